# Optimizing an MI355X kernel written in HIP

```python
import math
import jax, jax.numpy as jnp
from jax import lax
import numpy as np


D_MODEL = 1024
BATCH = 16
SEQ = 2048
DEPTH = 2

EPS = 1e-6
RET_HEADS = 4
RET_DK = 128
RET_DV = 128
RET_CHUNK = 128
ROPE_BASE = 10000.0
DA_PATTERNS = ((128, 1), (512, 4), (2048, 16))
DA_HEADS_PER_GROUP = 4
DA_HEADS = DA_HEADS_PER_GROUP * len(DA_PATTERNS)
DA_DH = 64
ML_HEADS = 4
ML_DK = 64
ML_DV = 128
ML_CHUNK = 128
ML_CONV = 4
D_FF = 2816
N_EXPERTS = 8
TOP_K = 2
D_FF_EXPERT = 3584

SPLIT_SIZES = (RET_HEADS * RET_DK, RET_HEADS * RET_DK, RET_HEADS * RET_DV, RET_HEADS * RET_DV,
               DA_HEADS * DA_DH, DA_HEADS * DA_DH, DA_HEADS * DA_DH,
               ML_HEADS * ML_DK, ML_HEADS * ML_DK, ML_HEADS * ML_DV, ML_HEADS * ML_DV, ML_HEADS, ML_HEADS,
               D_MODEL, D_MODEL, D_MODEL)
P_IN = sum(SPLIT_SIZES)

kernel_name = 'hybrid_gated_retention_dilattn_mlstm_moe'


def rms_norm(x, w):
    xf = x.astype(jnp.float32)
    y = xf * lax.rsqrt(jnp.mean(xf * xf, axis=-1, keepdims=True) + EPS)
    return (y * w.astype(jnp.float32)).astype(x.dtype)


def head_rms(x, w):
    xf = x.astype(jnp.float32)
    return xf * lax.rsqrt(jnp.mean(xf * xf, axis=-1, keepdims=True) + EPS) * w.astype(jnp.float32)


def rotary(x, pos):
    half = x.shape[-1] // 2
    inv = jnp.power(ROPE_BASE, -jnp.arange(half, dtype=jnp.float32) / half)
    ang = pos.astype(jnp.float32)[:, None] * inv[None, :]
    cos = jnp.cos(ang)[None, :, None, :]
    sin = jnp.sin(ang)[None, :, None, :]
    xf = x.astype(jnp.float32)
    x1, x2 = xf[..., :half], xf[..., half:]
    return jnp.concatenate([x1 * cos - x2 * sin, x1 * sin + x2 * cos], axis=-1)


def to_chunks(t, c):
    b, s = t.shape[:2]
    t = t.reshape((b, s // c, c) + t.shape[2:])
    return jnp.swapaxes(jnp.swapaxes(t, 0, 1), 2, 3)


def from_chunks(t):
    t = jnp.swapaxes(jnp.swapaxes(t, 2, 3), 0, 1)
    b, n, c = t.shape[:3]
    return t.reshape((b, n * c) + t.shape[3:])


def retention(q, k, v):
    B, S, H, DK = q.shape
    DV = v.shape[-1]
    C = RET_CHUNK
    q = q.astype(jnp.float32)
    k = k.astype(jnp.float32) * (DK ** -0.5)
    v = v.astype(jnp.float32)
    log_gamma = jnp.log1p(-jnp.exp2(-5.0 - jnp.arange(H, dtype=jnp.float32)))
    idx = jnp.arange(C, dtype=jnp.float32)
    rel = idx[:, None] - idx[None, :]
    intra = jnp.where(rel >= 0, jnp.exp(log_gamma[:, None, None] * jnp.maximum(rel, 0.0)), 0.0)
    q_dec = jnp.exp(log_gamma[:, None] * (idx + 1.0))[None, :, :, None]
    k_dec = jnp.exp(log_gamma[:, None] * (C - 1.0 - idx))[None, :, :, None]
    c_dec = jnp.exp(log_gamma * C)[None, :, None, None]

    def step(state, blk):
        qb, kb, vb = blk
        scores = jnp.einsum('bhik,bhjk->bhij', qb, kb) * intra
        out = (jnp.einsum('bhij,bhjv->bhiv', scores, vb)
               + jnp.einsum('bhik,bhkv->bhiv', qb, state) * q_dec)
        state = state * c_dec + jnp.einsum('bhjk,bhjv->bhkv', kb * k_dec, vb)
        return state, out

    state0 = jnp.zeros((B, H, DK, DV), jnp.float32)
    _, out = lax.scan(step, state0, (to_chunks(q, C), to_chunks(k, C), to_chunks(v, C)))
    return from_chunks(out)


def dilated_group(q, k, v, window, dilation):
    B, S, Hg, Dh = q.shape
    M = window // dilation
    L = -(-S // dilation)
    L = -(-L // M) * M
    nb = L // M
    S_pad = L * dilation

    def to_sub(t):
        t = jnp.pad(t, ((0, 0), (0, S_pad - S), (0, 0), (0, 0)))
        t = t.reshape(B, L, dilation, Hg, Dh).transpose(0, 2, 3, 1, 4)
        return t.reshape(B, dilation, Hg, nb, M, Dh)

    def with_prev(t):
        prev = jnp.pad(t[:, :, :, :-1], ((0, 0), (0, 0), (0, 0), (1, 0), (0, 0), (0, 0)))
        return jnp.concatenate([prev, t], axis=4)

    qs = to_sub(q)
    kk = with_prev(to_sub(k))
    vv = with_prev(to_sub(v))
    s = jnp.einsum('brhnqd,brhnkd->brhnqk', qs, kk) * (Dh ** -0.5)
    qi = jnp.arange(M)[:, None]
    kj = jnp.arange(2 * M)[None, :]
    dist = qi + M - kj
    band = (dist >= 0) & (dist <= M)
    first = (jnp.arange(nb)[:, None, None] == 0) & (kj[None] < M)
    valid = band[None] & jnp.logical_not(first)
    s = jnp.where(valid, s, -jnp.inf)
    m = jnp.max(s, axis=-1, keepdims=True)
    p = jnp.exp(s - m)
    l = jnp.sum(p, axis=-1, keepdims=True)
    o = jnp.einsum('brhnqk,brhnkd->brhnqd', p, vv) / l
    lse = (m + jnp.log(l))[..., 0]
    o = o.reshape(B, dilation, Hg, L, Dh).transpose(0, 3, 1, 2, 4).reshape(B, S_pad, Hg, Dh)[:, :S]
    lse = lse.reshape(B, dilation, Hg, L).transpose(0, 3, 1, 2).reshape(B, S_pad, Hg)[:, :S]
    return o, lse


def dilated_attention(q, k, v):
    outs, lses = [], []
    for g, (window, dilation) in enumerate(DA_PATTERNS):
        sl = slice(g * DA_HEADS_PER_GROUP, (g + 1) * DA_HEADS_PER_GROUP)
        o, lse = dilated_group(q[:, :, sl], k[:, :, sl], v[:, :, sl], window, dilation)
        outs.append(o)
        lses.append(lse)
    outs = jnp.stack(outs, axis=0)
    w = jax.nn.softmax(jnp.stack(lses, axis=0), axis=0)
    return jnp.sum(w[..., None] * outs, axis=0)


def causal_dwconv(x, w):
    K, ch = w.shape
    return lax.conv_general_dilated(x, w[:, None, :].astype(x.dtype), window_strides=(1,),
                                    padding=((K - 1, 0),), dimension_numbers=('NWC', 'WIO', 'NWC'),
                                    feature_group_count=ch)


def mlstm(q, k, v, i_pre, f_pre):
    B, S, H, DK = q.shape
    DV = v.shape[-1]
    C = ML_CHUNK
    q = q.astype(jnp.float32)
    k = k.astype(jnp.float32) * (DK ** -0.5)
    v = v.astype(jnp.float32)
    ig = i_pre.astype(jnp.float32)
    logf = jax.nn.log_sigmoid(f_pre.astype(jnp.float32))
    causal = jnp.tril(jnp.ones((C, C), dtype=bool))

    def step(carry, blk):
        Cm, nm, mm = carry
        qb, kb, vb, ib, fb = blk
        b = jnp.cumsum(fb, axis=-1)
        D = jnp.where(causal, b[..., :, None] - b[..., None, :] + ib[..., None, :], -jnp.inf)
        inter = b + mm[..., None]
        m = jnp.maximum(inter, jnp.max(D, axis=-1))
        Dw = jnp.exp(D - m[..., None])
        wi = jnp.exp(inter - m)
        s = jnp.einsum('bhid,bhjd->bhij', qb, kb) * Dw
        num = jnp.einsum('bhij,bhjv->bhiv', s, vb) + wi[..., None] * jnp.einsum('bhid,bhdv->bhiv', qb, Cm)
        den = jnp.sum(s, axis=-1) + wi * jnp.einsum('bhid,bhd->bhi', qb, nm)
        h = num / jnp.maximum(jnp.abs(den), jnp.exp(-m))[..., None]
        m_new = m[..., -1]
        wk = jnp.exp(b[..., -1:] - b + ib - m_new[..., None])
        wc = jnp.exp(b[..., -1] + mm - m_new)
        Cm = wc[..., None, None] * Cm + jnp.einsum('bhj,bhjd,bhjv->bhdv', wk, kb, vb)
        nm = wc[..., None] * nm + jnp.einsum('bhj,bhjd->bhd', wk, kb)
        return (Cm, nm, m_new), h

    carry0 = (jnp.zeros((B, H, DK, DV), jnp.float32), jnp.zeros((B, H, DK), jnp.float32),
              jnp.zeros((B, H), jnp.float32))
    _, out = lax.scan(step, carry0, (to_chunks(q, C), to_chunks(k, C), to_chunks(v, C),
                                     to_chunks(ig, C), to_chunks(logf, C)))
    return from_chunks(out)


def hybrid_mixer(h, w_in, ret_norm_w, da_q_norm_w, da_k_norm_w, ml_conv_w, ml_i_bias, ml_f_bias,
                 ml_norm_w, w_br_ret, w_br_da, w_br_ml, w_out, pos):
    B, S, _ = h.shape
    dt = h.dtype
    z = h @ w_in
    offsets = np.cumsum(np.array(SPLIT_SIZES))[:-1].tolist()
    (rq, rk, rv, rg, dq, dk, dv, mq, mk, mv, mo, mi, mf, g_ret, g_da, g_ml) = jnp.split(z, offsets, axis=-1)

    r_out = retention(rotary(rq.reshape(B, S, RET_HEADS, RET_DK), pos),
                      rotary(rk.reshape(B, S, RET_HEADS, RET_DK), pos),
                      rv.reshape(B, S, RET_HEADS, RET_DV))
    r_out = head_rms(r_out, ret_norm_w.reshape(RET_HEADS, RET_DV)).reshape(B, S, RET_HEADS * RET_DV)
    o_ret = (r_out * jax.nn.silu(rg.astype(jnp.float32))).astype(dt)

    qa = head_rms(dq.reshape(B, S, DA_HEADS, DA_DH), da_q_norm_w)
    ka = head_rms(dk.reshape(B, S, DA_HEADS, DA_DH), da_k_norm_w)
    va = dv.reshape(B, S, DA_HEADS, DA_DH).astype(jnp.float32)
    o_da = dilated_attention(qa, ka, va).reshape(B, S, DA_HEADS_PER_GROUP * DA_DH).astype(dt)

    qk = jax.nn.silu(causal_dwconv(jnp.concatenate([mq, mk], axis=-1), ml_conv_w))
    mq_c, mk_c = jnp.split(qk, 2, axis=-1)
    m_out = mlstm(mq_c.reshape(B, S, ML_HEADS, ML_DK), mk_c.reshape(B, S, ML_HEADS, ML_DK),
                  mv.reshape(B, S, ML_HEADS, ML_DV), mi + ml_i_bias, mf + ml_f_bias)
    m_out = head_rms(m_out, ml_norm_w.reshape(ML_HEADS, ML_DV)).reshape(B, S, ML_HEADS * ML_DV)
    o_ml = (m_out * jax.nn.sigmoid(mo.astype(jnp.float32))).astype(dt)

    y = (jax.nn.sigmoid(g_ret) * (o_ret @ w_br_ret)
         + jax.nn.sigmoid(g_da) * (o_da @ w_br_da)
         + jax.nn.sigmoid(g_ml) * (o_ml @ w_br_ml))
    return y @ w_out


def swiglu(h, w_gate, w_up, w_down):
    return (jax.nn.silu(h @ w_gate) * (h @ w_up)) @ w_down


def moe_swiglu(h, w_router, b_router, w_gate, w_up, w_down):
    B, S, D = h.shape
    ht = h.reshape(B * S, D)
    logits = (ht @ w_router).astype(jnp.float32) + b_router.astype(jnp.float32)
    top_v, top_i = lax.top_k(logits, TOP_K)
    probs = jax.nn.softmax(top_v, axis=-1)
    gates = jnp.sum(jax.nn.one_hot(top_i, N_EXPERTS, dtype=jnp.float32) * probs[..., None], axis=1)
    out = jnp.zeros((B * S, D), jnp.float32)
    for e in range(N_EXPERTS):
        a = jax.nn.silu(ht @ w_gate[e]) * (ht @ w_up[e])
        out = out + gates[:, e:e + 1] * (a @ w_down[e]).astype(jnp.float32)
    return out.astype(h.dtype).reshape(B, S, D)


def setup_inputs(seed: int = 0) -> dict:
    key = jax.random.key(seed)
    ks = jax.random.split(key, 24)
    f32 = jnp.float32

    def nrm(k, shape, scale):
        return jax.random.normal(k, shape, f32) * scale

    n_dense = (DEPTH + 1) // 2
    n_moe = DEPTH // 2
    ret_w = RET_HEADS * RET_DV
    da_out = DA_HEADS_PER_GROUP * DA_DH
    ml_w = ML_HEADS * ML_DV
    return {
        'x': nrm(ks[0], (BATCH, SEQ, D_MODEL), 1.0),
        'norm1_w': 1.0 + nrm(ks[1], (DEPTH, D_MODEL), 0.05),
        'w_in': nrm(ks[2], (DEPTH, D_MODEL, P_IN), D_MODEL ** -0.5),
        'ret_norm_w': 1.0 + nrm(ks[3], (DEPTH, ret_w), 0.05),
        'da_q_norm_w': 1.0 + nrm(ks[4], (DEPTH, DA_DH), 0.05),
        'da_k_norm_w': 1.0 + nrm(ks[5], (DEPTH, DA_DH), 0.05),
        'ml_conv_w': nrm(ks[6], (DEPTH, ML_CONV, 2 * ML_HEADS * ML_DK), ML_CONV ** -0.5),
        'ml_i_bias': nrm(ks[7], (DEPTH, ML_HEADS), 0.1),
        'ml_f_bias': jnp.linspace(3.0, 6.0, ML_HEADS, dtype=f32)[None, :] + nrm(ks[8], (DEPTH, ML_HEADS), 0.1),
        'ml_norm_w': 1.0 + nrm(ks[9], (DEPTH, ml_w), 0.05),
        'w_br_ret': nrm(ks[10], (DEPTH, ret_w, D_MODEL), ret_w ** -0.5),
        'w_br_da': nrm(ks[11], (DEPTH, da_out, D_MODEL), da_out ** -0.5),
        'w_br_ml': nrm(ks[12], (DEPTH, ml_w, D_MODEL), ml_w ** -0.5),
        'w_out': nrm(ks[13], (DEPTH, D_MODEL, D_MODEL), D_MODEL ** -0.5),
        'norm2_w': 1.0 + nrm(ks[14], (DEPTH, D_MODEL), 0.05),
        'ffn_w_gate': nrm(ks[15], (n_dense, D_MODEL, D_FF), D_MODEL ** -0.5),
        'ffn_w_up': nrm(ks[16], (n_dense, D_MODEL, D_FF), D_MODEL ** -0.5),
        'ffn_w_down': nrm(ks[17], (n_dense, D_FF, D_MODEL), D_FF ** -0.5),
        'moe_w_router': nrm(ks[18], (n_moe, D_MODEL, N_EXPERTS), D_MODEL ** -0.5),
        'moe_b_router': nrm(ks[19], (n_moe, N_EXPERTS), 0.01),
        'moe_w_gate': nrm(ks[20], (n_moe, N_EXPERTS, D_MODEL, D_FF_EXPERT), D_MODEL ** -0.5),
        'moe_w_up': nrm(ks[21], (n_moe, N_EXPERTS, D_MODEL, D_FF_EXPERT), D_MODEL ** -0.5),
        'moe_w_down': nrm(ks[22], (n_moe, N_EXPERTS, D_FF_EXPERT, D_MODEL), D_FF_EXPERT ** -0.5),
    }


def reference(x, norm1_w, w_in, ret_norm_w, da_q_norm_w, da_k_norm_w, ml_conv_w, ml_i_bias, ml_f_bias,
              ml_norm_w, w_br_ret, w_br_da, w_br_ml, w_out, norm2_w, ffn_w_gate, ffn_w_up, ffn_w_down,
              moe_w_router, moe_b_router, moe_w_gate, moe_w_up, moe_w_down):
    pos = jnp.arange(x.shape[1], dtype=jnp.int32)
    for layer in range(DEPTH):
        h = rms_norm(x, norm1_w[layer])
        x = x + hybrid_mixer(h, w_in[layer], ret_norm_w[layer], da_q_norm_w[layer], da_k_norm_w[layer],
                             ml_conv_w[layer], ml_i_bias[layer], ml_f_bias[layer], ml_norm_w[layer],
                             w_br_ret[layer], w_br_da[layer], w_br_ml[layer], w_out[layer], pos)
        h = rms_norm(x, norm2_w[layer])
        j = layer // 2
        if layer % 2 == 0:
            x = x + swiglu(h, ffn_w_gate[j], ffn_w_up[j], ffn_w_down[j])
        else:
            x = x + moe_swiglu(h, moe_w_router[j], moe_b_router[j], moe_w_gate[j], moe_w_up[j], moe_w_down[j])
    return x
```

```cpp
#include <hip/hip_runtime.h>
#include <stdio.h>
#include <stdint.h>

#define LAS __attribute__((address_space(3)))
#define GAS __attribute__((address_space(1)))
typedef unsigned short bf16_t;
typedef short bf16x8 __attribute__((ext_vector_type(8)));
typedef short s16x4 __attribute__((ext_vector_type(4)));
typedef float f32x4 __attribute__((ext_vector_type(4)));
typedef float f32x2 __attribute__((ext_vector_type(2)));
typedef unsigned u32x4 __attribute__((ext_vector_type(4)));
typedef unsigned u32x2 __attribute__((ext_vector_type(2)));
typedef int i32x8 __attribute__((ext_vector_type(8)));
typedef int i32x4 __attribute__((ext_vector_type(4)));

constexpr int BATCH = 16, SEQ = 2048, D = 1024, T = BATCH * SEQ;
constexpr int NGRP = 2, BG = BATCH / NGRP, TG = BG * SEQ;
constexpr int PIN = 8968, NZ = 9216;
constexpr int ZC_RQ = 0, ZC_RK = 512, ZC_RV = 1024, ZC_RG = 1536, ZC_DQ = 2048, ZC_DK = 2816, ZC_DV = 3584;
constexpr int ZC_MQ = 4352, ZC_MK = 4608, ZC_MV = 4864, ZC_MO = 5376, ZC_GATE = 5888, ZC_SG = 6144;
constexpr int OW = 1280, OC_RET = 0, OC_DA = 512, OC_ML = 768;
constexpr int FF = 2816, FFE = 3584, NE = 8, FFC = 896, NCHUNK = 4;
constexpr int MAXSLOT = 2 * T + NE * 256, MAXMT = MAXSLOT / 256;
constexpr float EPS = 1e-6f;
constexpr float LOG2E = 1.4426950408889634f;

typedef __bf16 bf16x2_t __attribute__((ext_vector_type(2)));
typedef float f32x2_t __attribute__((ext_vector_type(2)));
__device__ __forceinline__ unsigned cvt_pk_bf16(float lo, float hi) { const f32x2_t v = {lo, hi}; return __builtin_bit_cast(unsigned, __builtin_convertvector(v, bf16x2_t)); }
__device__ __forceinline__ unsigned cvt_pk4_fp8(float a, float b, float c, float d) { int p = 0; p = __builtin_amdgcn_cvt_pk_fp8_f32(a, b, p, false); p = __builtin_amdgcn_cvt_pk_fp8_f32(c, d, p, true); return (unsigned)p; }
constexpr float ACT8_SCALE = 4.0f, W8_SCALE = 128.0f;
constexpr int ACT8_E8M0 = 0x7D7D7D7D, W8_E8M0 = 0x78787878;
__device__ __forceinline__ float bf_lo(unsigned u) { return __uint_as_float(u << 16); }
__device__ __forceinline__ float bf_hi(unsigned u) { return __uint_as_float(u & 0xffff0000u); }
__device__ __forceinline__ float bf2f(bf16_t b) { return __uint_as_float(((unsigned)b) << 16); }
__device__ __forceinline__ float fast_exp2(float x) { return __builtin_amdgcn_exp2f(x); }
__device__ __forceinline__ float fast_rcp(float x) { return __builtin_amdgcn_rcpf(x); }
__device__ __forceinline__ float sigmoidf_(float x) { return fast_rcp(1.0f + fast_exp2(-x * LOG2E)); }
__device__ __forceinline__ float siluf_(float x) { return x * sigmoidf_(x); }

namespace pg8 {
constexpr int BM = 256, BK = 64, HALF = 128, HTB = HALF * BK * 2, STAGE_BYTES = 8 * HTB, NXCD = 8, WGM = 8;
__host__ __device__ __forceinline__ int lds_byte(int r, int c) { const int st = (r >> 4) * 2 + (c >> 5), rr = r & 15, cc = c & 31, ob = rr * 64 + cc * 2; return st * 1024 + (ob ^ (((ob >> 9) & 1) << 5)); }
__host__ __device__ __forceinline__ void stage_rc(int b, int& R, int& C) { const int st = b / 1024, sb = b % 1024, swz = sb ^ (((sb >> 9) & 1) << 5); R = (st >> 1) * 16 + swz / 64; C = (st & 1) * 32 + (swz % 64) / 2; }
__host__ __device__ __forceinline__ int perm32(int rho) { const int n = rho >> 4, i = rho & 15; return 8 * (i >> 2) + 4 * n + (i & 3); }

struct Unit { int pm, pn, e; };
struct Gemm { const void* A; const void* Bt; int lda, ldb, nt; unsigned bstride; };

struct StaticOrder {
    int nM, nN, nwg, G, c;
    __device__ void init(int M, int N, int G_, int c_) { nM = M / BM; nN = N / BM; nwg = nM * nN; G = G_; c = c_; }
    __device__ bool next(int i, Unit& u) const {
        const long L = (long)i * G + c; if (L >= nwg) return false;
        int wgid = (int)L; { const int q = nwg / NXCD, r = nwg % NXCD, xcd = wgid % NXCD, off = wgid / NXCD; wgid = (xcd < r ? xcd * (q + 1) : r * (q + 1) + (xcd - r) * q) + off; }
        const int nig = WGM * nN, gid = wgid / nig, fm = gid * WGM, gsz = (nM - fm) < WGM ? (nM - fm) : WGM;
        u.pm = fm + ((wgid % nig) % gsz); u.pn = (wgid % nig) / gsz; u.e = 0; return true;
    }
    __device__ __forceinline__ void a_ready(const Unit&) const {}
    __device__ __forceinline__ void done(const Unit&) const {}
};
struct ListOrder : StaticOrder {
    unsigned long long tl_lo, tl_hi;
    __device__ bool next(int i, Unit& u) const {
        if (!StaticOrder::next(i, u)) return false;
        const int k = u.pn; const unsigned long long w = k < 10 ? tl_lo : tl_hi; u.pn = (int)((w >> (6 * (k < 10 ? k : k - 10))) & 63ull); return true;
    }
};
struct MoeOrder : StaticOrder {
    int t1, t2, t3, t4, t5, t6, t7;
    __device__ void init_moe(const int* ts, int N, int G_, int c_) {
#define RFL(x) __builtin_amdgcn_readfirstlane(x)
        t1 = RFL(ts[1]); t2 = RFL(ts[2]); t3 = RFL(ts[3]); t4 = RFL(ts[4]); t5 = RFL(ts[5]); t6 = RFL(ts[6]); t7 = RFL(ts[7]);
        init(RFL(ts[8]) * BM, N, G_, c_);
#undef RFL
    }
    __device__ bool next(int i, Unit& u) const {
        if (!StaticOrder::next(i, u)) return false;
        const int p = u.pm; u.e = __builtin_amdgcn_readfirstlane((p >= t1) + (p >= t2) + (p >= t3) + (p >= t4) + (p >= t5) + (p >= t6) + (p >= t7)); return true;
    }
};

template <class Epi, class Sched, bool ALIGN_EPI = false, bool SP2 = false, bool FP8 = false>
__device__ __forceinline__ void gemm_phase(LAS unsigned char* lds, const Gemm g, const Sched& S, const Epi& E) {
    int tid_ = threadIdx.x; asm volatile("" : "+v"(tid_));
    const int tid = tid_, wid = __builtin_amdgcn_readfirstlane(tid >> 6), lane = tid & 63, wr = wid >> 2, wc = wid & 3, fr = lane & 15, fq = lane >> 4;
    int nt_ = g.nt; asm volatile("" : "+s"(nt_)); const int nt = nt_;
    unsigned voffA, voffB;
    { int R, C; stage_rc(tid * 16, R, C); const int Rb = Epi::PERM ? ((R & ~31) + perm32(R & 31)) : R;
        voffA = (unsigned)(R * g.lda + C * 2); voffB = (unsigned)(Rb * g.ldb + C * 2); }
    const size_t qstepA = (size_t)64 * g.lda, qstepB = (size_t)64 * g.ldb;
    const size_t kstep = (size_t)(BK * 2);
    const size_t hstepA = (size_t)HALF * g.lda, hstepB = (size_t)HALF * g.ldb;
    const size_t tstepA = 2 * hstepA, tstepB = 2 * hstepB;
    const unsigned ldsw = (unsigned)wid * 1024u;
    const int aoff = lds_byte(wr * 64 + fr, fq * 8), boff = lds_byte(wc * 32 + fr, fq * 8);
#define PG8_SA(b, h) (((b) * 2 + (h)) * HTB)
#define PG8_SB(b, h) ((4 + (b) * 2 + (h)) * HTB)
#define PG8_STAGE(bufoff, gbase, voff) do { _Pragma("unroll") for (int _i = 0; _i < 2; ++_i) { \
        unsigned long long _gb = (unsigned long long)(gbase) + (_i ? q##voff : 0); asm volatile("" : "+s"(_gb));     \
        __builtin_amdgcn_global_load_lds((const GAS unsigned*)((const GAS char*)_gb + (voff)), (LAS unsigned*)(lds + (bufoff) + ldsw + _i * 8192), 16, 0, 0); } } while (0)
#define qvoffA qstepA
#define qvoffB qstepB
#define PG8_LDA(dst, b, h) do { _Pragma("unroll") for (int m = 0; m < 4; ++m) _Pragma("unroll") for (int k = 0; k < 2; ++k) dst[m][k] = *(const LAS bf16x8*)(lds + PG8_SA(b, h) + aoff + m * 2048 + k * 1024); } while (0)
#define PG8_LDB(dst, b, h) do { _Pragma("unroll") for (int n = 0; n < 2; ++n) _Pragma("unroll") for (int k = 0; k < 2; ++k) dst[n][k] = *(const LAS bf16x8*)(lds + PG8_SB(b, h) + boff + n * 2048 + k * 1024); } while (0)
#define PG8_CAT(x) __builtin_shufflevector(__builtin_bit_cast(i32x4, (x)[0]), __builtin_bit_cast(i32x4, (x)[1]), 0, 1, 2, 3, 4, 5, 6, 7)
#define PG8_MMA(ai, bj, At, Bt) do { __builtin_amdgcn_s_setprio(2); _Pragma("unroll") for (int m = 0; m < 4; ++m) _Pragma("unroll") for (int n = 0; n < 2; ++n) { \
        if constexpr (FP8) acc[ai][bj][m][n] = __builtin_amdgcn_mfma_scale_f32_16x16x128_f8f6f4(PG8_CAT(Bt[n]), PG8_CAT(At[m]), acc[ai][bj][m][n], 0, 0, 0, W8_E8M0, 0, ACT8_E8M0); \
        else { _Pragma("unroll") for (int k = 0; k < 2; ++k) acc[ai][bj][m][n] = __builtin_amdgcn_mfma_f32_16x16x32_bf16(Bt[n][k], At[m][k], acc[ai][bj][m][n], 0, 0, 0); } } \
        __builtin_amdgcn_s_setprio(0); } while (0)
#define PG8_WAIT_V(n) asm volatile("s_waitcnt vmcnt(" #n ")" ::: "memory")
#define PG8_WAIT_L(n) asm volatile("s_waitcnt lgkmcnt(" #n ")" ::: "memory")
#define PG8_BAR __builtin_amdgcn_s_barrier()
#define PG8_SCHED __builtin_amdgcn_sched_barrier(0)
    Unit cur, nxt; int ui = 0;
    if (!S.next(0, cur)) return;
    f32x4 acc[2][2][4][2];
#pragma unroll
    for (int a = 0; a < 2; ++a)
#pragma unroll
        for (int b = 0; b < 2; ++b)
#pragma unroll
            for (int m = 0; m < 4; ++m)
#pragma unroll
                for (int n = 0; n < 2; ++n) acc[a][b][m][n] = (f32x4){0.f, 0.f, 0.f, 0.f};
    bf16x8 At[4][2], B0[2][2], B1[2][2];
    const char* cA = (const char*)g.A + (size_t)cur.pm * tstepA; const char* cB = (const char*)g.Bt + (size_t)((unsigned)cur.e * g.bstride) + (size_t)cur.pn * tstepB;
    S.a_ready(cur);
    if constexpr (SP2) {
        PG8_STAGE(PG8_SB(0, 0), cB, voffB); PG8_STAGE(PG8_SB(0, 1), cB + hstepB, voffB); PG8_STAGE(PG8_SA(0, 0), cA, voffA); PG8_STAGE(PG8_SA(0, 1), cA + hstepA, voffA);
        if (wr == 1) PG8_BAR;
        PG8_WAIT_V(2); PG8_BAR;
        PG8_STAGE(PG8_SB(1, 0), cB + kstep, voffB); PG8_STAGE(PG8_SA(1, 0), cA + kstep, voffA); PG8_STAGE(PG8_SB(1, 1), cB + hstepB + kstep, voffB);
        PG8_WAIT_V(6); PG8_BAR;
    } else {
        PG8_STAGE(PG8_SB(0, 0), cB, voffB); PG8_STAGE(PG8_SA(0, 0), cA, voffA); PG8_STAGE(PG8_SB(0, 1), cB + hstepB, voffB); PG8_STAGE(PG8_SA(0, 1), cA + hstepA, voffA);
        if (wr == 1) PG8_BAR;
        PG8_WAIT_V(4); PG8_BAR;
        PG8_STAGE(PG8_SB(1, 0), cB + kstep, voffB); PG8_STAGE(PG8_SA(1, 0), cA + kstep, voffA); PG8_STAGE(PG8_SB(1, 1), cB + hstepB + kstep, voffB);
        PG8_WAIT_V(6); PG8_BAR;
        PG8_LDB(B0, 0, 0);
    }
    for (;;) {
        const bool has_next = S.next(ui + 1, nxt);
        const char* nA = has_next ? (const char*)g.A + (size_t)nxt.pm * tstepA : cA;
        const char* nB = has_next ? (const char*)g.Bt + (size_t)((unsigned)nxt.e * g.bstride) + (size_t)nxt.pn * tstepB : cB;
#pragma unroll 1
        for (int t = 0; t < nt; t += 2) {
            const bool last = (t == nt - 2);
            const char* a1 = cA + (size_t)(t + 1) * kstep;
            const char* a2 = last ? nA : cA + (size_t)(t + 2) * kstep; const char* b2 = last ? nB : cB + (size_t)(t + 2) * kstep;
            const char* a3 = a2 + kstep; const char* b3 = b2 + kstep;
            if (last && has_next) S.a_ready(nxt);
            if constexpr (SP2) {
            PG8_LDB(B0, 0, 0); PG8_LDB(B1, 0, 1); PG8_SCHED; PG8_LDA(At, 0, 0); PG8_STAGE(PG8_SA(1, 1), a1 + hstepA, voffA);
            PG8_WAIT_V(8); PG8_WAIT_L(0); PG8_BAR; PG8_MMA(0, 0, At, B0); PG8_MMA(0, 1, At, B1); PG8_BAR; PG8_SCHED;
            PG8_LDA(At, 0, 1); PG8_STAGE(PG8_SB(0, 0), b2, voffB); PG8_STAGE(PG8_SB(0, 1), b2 + hstepB, voffB); PG8_STAGE(PG8_SA(0, 0), a2, voffA);
            PG8_WAIT_V(8); PG8_WAIT_L(0); PG8_BAR; PG8_MMA(1, 0, At, B0); PG8_MMA(1, 1, At, B1); PG8_BAR; PG8_SCHED;
            PG8_LDB(B0, 1, 0); PG8_LDB(B1, 1, 1); PG8_SCHED; PG8_LDA(At, 1, 0); PG8_STAGE(PG8_SA(0, 1), a2 + hstepA, voffA);
            PG8_WAIT_V(8); PG8_WAIT_L(0); PG8_BAR; PG8_MMA(0, 0, At, B0); PG8_MMA(0, 1, At, B1); PG8_BAR; PG8_SCHED;
            PG8_LDA(At, 1, 1); PG8_STAGE(PG8_SB(1, 0), b3, voffB); PG8_STAGE(PG8_SB(1, 1), b3 + hstepB, voffB); PG8_STAGE(PG8_SA(1, 0), a3, voffA);
            PG8_WAIT_V(8); PG8_WAIT_L(0); PG8_BAR; PG8_MMA(1, 0, At, B0); PG8_MMA(1, 1, At, B1); PG8_BAR; PG8_SCHED;
            } else {
            PG8_LDA(At, 0, 0); PG8_STAGE(PG8_SA(1, 1), a1 + hstepA, voffA);
            PG8_WAIT_L(8); PG8_BAR; PG8_WAIT_L(0); PG8_MMA(0, 0, At, B0); PG8_BAR; PG8_SCHED;
            PG8_LDB(B1, 0, 1); PG8_STAGE(PG8_SB(0, 0), b2, voffB);
            PG8_BAR; PG8_WAIT_L(0); PG8_MMA(0, 1, At, B1); PG8_BAR;
            PG8_LDA(At, 0, 1); PG8_STAGE(PG8_SA(0, 0), a2, voffA);
            PG8_WAIT_V(10); PG8_BAR; PG8_WAIT_L(0); PG8_MMA(1, 0, At, B0); PG8_BAR; PG8_SCHED;
            PG8_LDB(B0, 1, 0); PG8_STAGE(PG8_SB(0, 1), b2 + hstepB, voffB);
            PG8_WAIT_V(6); PG8_BAR; PG8_MMA(1, 1, At, B1); PG8_BAR; PG8_SCHED;
            PG8_LDA(At, 1, 0); PG8_STAGE(PG8_SA(0, 1), a2 + hstepA, voffA);
            PG8_WAIT_L(8); PG8_BAR; PG8_WAIT_L(0); PG8_MMA(0, 0, At, B0); PG8_BAR; PG8_SCHED;
            PG8_LDB(B1, 1, 1); PG8_STAGE(PG8_SB(1, 0), b3, voffB);
            PG8_BAR; PG8_WAIT_L(0); PG8_MMA(0, 1, At, B1); PG8_BAR;
            PG8_LDA(At, 1, 1); PG8_STAGE(PG8_SA(1, 0), a3, voffA);
            PG8_WAIT_V(10); PG8_BAR; PG8_WAIT_L(0); PG8_MMA(1, 0, At, B0); PG8_BAR; PG8_SCHED;
            PG8_LDB(B0, 0, 0); PG8_STAGE(PG8_SB(1, 1), b3 + hstepB, voffB);
            PG8_WAIT_V(6); PG8_BAR; PG8_MMA(1, 1, At, B1); PG8_BAR; PG8_SCHED;
            }
        }
        if constexpr (ALIGN_EPI) { if (wr == 0) PG8_BAR; }
        E(acc, cur, wr, wc, fr, fq, ui); S.done(cur);
        if (!has_next) break;
#pragma unroll
        for (int a = 0; a < 2; ++a)
#pragma unroll
            for (int b = 0; b < 2; ++b)
#pragma unroll
                for (int m = 0; m < 4; ++m)
#pragma unroll
                    for (int n = 0; n < 2; ++n) acc[a][b][m][n] = (f32x4){0.f, 0.f, 0.f, 0.f};
        cur = nxt; cA = nA; cB = nB; ++ui;
        if constexpr (ALIGN_EPI) { if (wr == 1) PG8_BAR; }
        if constexpr (!SP2) PG8_LDB(B0, 0, 0);
    }
    PG8_WAIT_V(0);
    if constexpr (!ALIGN_EPI) { if (wr == 0) PG8_BAR; }
    PG8_BAR;
#undef PG8_SA
#undef PG8_SB
#undef PG8_STAGE
#undef qvoffA
#undef qvoffB
#undef PG8_LDA
#undef PG8_LDB
#undef PG8_MMA
#undef PG8_CAT
#undef PG8_WAIT_V
#undef PG8_WAIT_L
#undef PG8_BAR
#undef PG8_SCHED
}

__device__ __forceinline__ float rstd_from_partials(const float* ssq, int row) {
    const f32x4* sp = (const f32x4*)(ssq + (size_t)row * 16);
    const f32x4 s0 = sp[0], s1 = sp[1], s2 = sp[2], s3 = sp[3];
    const f32x4 s = (s0 + s1) + (s2 + s3);
    return __builtin_amdgcn_rsqf(((s[0] + s[1]) + (s[2] + s[3])) * (1.0f / D) + EPS);
}
template <class Sched>
__device__ __forceinline__ void fill_rstd_table(const Sched& S, const float* ssq, LAS float* rt, int max_units) {
    int tid = threadIdx.x; asm volatile("" : "+v"(tid));
    const int half = tid >> 8, r = tid & 255;
#pragma unroll 1
    for (int i = 0; i < max_units; i += 2) { Unit u; if (S.next(i + half, u)) rt[(i + half) * BM + r] = rstd_from_partials(ssq, u.pm * BM + r); }
    __syncthreads();
}
__device__ __forceinline__ u32x4 pack8(const f32x4 a, const f32x4 b) { u32x4 w; w.x = cvt_pk_bf16(a[0], a[1]); w.y = cvt_pk_bf16(a[2], a[3]); w.z = cvt_pk_bf16(b[0], b[1]); w.w = cvt_pk_bf16(b[2], b[3]); return w; }

struct EpiG1 {
    static constexpr bool PERM = true;
    bf16_t* Z; float* gates; const LAS float* rt; const float* rope; const float* qw; const float* kw; int one_pm = 0;
    __device__ __forceinline__ void operator()(const f32x4 (&acc)[2][2][4][2], const Unit& u, int wr, int wc, int fr, int fq, int ui) const {
        const int row0 = u.pm * BM + wr * 64 + fr, pn = u.pn;
        const int kind = pn < 4 ? 0 : (pn < 8 ? 1 : (pn < 14 ? 2 : (pn < 23 ? 1 : (pn == 23 ? 3 : 4))));
        float rsv[8];
#pragma unroll
        for (int rg = 0; rg < 8; ++rg) rsv[rg] = rt[(one_pm ? 0 : ui) * BM + wr * 64 + fr + (rg >> 2) * HALF + (rg & 3) * 16];
        f32x4 nw[2][2];
        if (kind == 2) { const float* w = pn < 11 ? qw : kw;
#pragma unroll
            for (int bj = 0; bj < 2; ++bj) { nw[bj][0] = *(const f32x4*)(w + 32 * bj + 8 * fq); nw[bj][1] = *(const f32x4*)(w + 32 * bj + 8 * fq + 4); } }
#pragma unroll
        for (int ai = 0; ai < 2; ++ai) {
            f32x4 rcs[4], rsn[4];
            if (kind == 0) {
#pragma unroll
                for (int m = 0; m < 4; ++m) { const int pos = (row0 + ai * HALF + m * 16) & (SEQ - 1), i0 = 16 * wc + 4 * fq; rcs[m] = *(const f32x4*)(rope + pos * 64 + i0); rsn[m] = *(const f32x4*)(rope + SEQ * 64 + pos * 64 + i0); } }
#pragma unroll
            for (int m = 0; m < 4; ++m) {
                const int row = row0 + ai * HALF + m * 16;
                const float rs = rsv[ai * 4 + m];
                f32x4 v[2][2];
#pragma unroll
                for (int bj = 0; bj < 2; ++bj)
#pragma unroll
                    for (int n = 0; n < 2; ++n) v[bj][n] = acc[ai][bj][m][n] * rs;
                bf16_t* zrow = Z + (size_t)row * NZ;
                if (kind == 0) {
                    const f32x4 cs = rcs[m], sn = rsn[m];
#pragma unroll
                    for (int bj = 0; bj < 2; ++bj) {
                        const f32x4 a = v[bj][0], b = v[bj][1];
                        const f32x4 o0 = {a[0] * cs[0] - a[1] * sn[0], a[0] * sn[0] + a[1] * cs[0], a[2] * cs[1] - a[3] * sn[1], a[2] * sn[1] + a[3] * cs[1]};
                        const f32x4 o1 = {b[0] * cs[2] - b[1] * sn[2], b[0] * sn[2] + b[1] * cs[2], b[2] * cs[3] - b[3] * sn[3], b[2] * sn[3] + b[3] * cs[3]};
                        *(u32x4*)(zrow + pn * BM + bj * HALF + wc * 32 + fq * 8) = pack8(o0, o1);
                    }
                } else if (kind == 1) {
#pragma unroll
                    for (int bj = 0; bj < 2; ++bj) *(u32x4*)(zrow + pn * BM + bj * HALF + wc * 32 + fq * 8) = pack8(v[bj][0], v[bj][1]);
                } else if (kind == 2) {
                    float ss = 0.f;
#pragma unroll
                    for (int bj = 0; bj < 2; ++bj)
#pragma unroll
                        for (int n = 0; n < 2; ++n) { const f32x4 x = v[bj][n]; ss += (x[0] * x[0] + x[1] * x[1]) + (x[2] * x[2] + x[3] * x[3]); }
                    ss += __shfl_xor(ss, 16); ss += __shfl_xor(ss, 32);
                    const bool isq = pn < 11;
                    const float hr = __builtin_amdgcn_rsqf(ss * (1.0f / 64.0f) + EPS) * (isq ? 0.125f * LOG2E : 1.0f);
                    const int head = 4 * (pn - (isq ? 8 : 11)) + wc;
                    bf16_t* dst = zrow + (isq ? ZC_DQ : ZC_DK) + head * 64;
#pragma unroll
                    for (int bj = 0; bj < 2; ++bj) {
                        const int dim = 32 * bj + 8 * fq;
                        *(u32x4*)(dst + dim) = pack8(v[bj][0] * nw[bj][0] * hr, v[bj][1] * nw[bj][1] * hr);
                    }
                } else if (kind == 3) {
                    if (wc == 0 && fq == 0) { float* gp = gates + (size_t)row * 8; *(f32x4*)gp = v[0][0]; *(f32x4*)(gp + 4) = v[0][1]; }
                } else {
#pragma unroll
                    for (int bj = 0; bj < 2; ++bj) {
                        f32x4 a = v[bj][0], b = v[bj][1];
#pragma unroll
                        for (int e = 0; e < 4; ++e) { a[e] = sigmoidf_(a[e]); b[e] = sigmoidf_(b[e]); }
                        *(u32x4*)(zrow + pn * BM + bj * HALF + wc * 32 + fq * 8) = pack8(a, b);
                    }
                }
                asm volatile("" ::: "memory");
            }
        }
    }
};
struct EpiGate8 {
    static constexpr bool PERM = true;
    bf16_t* Z; const LAS float* rt; int one_pm = 0;
    __device__ __forceinline__ void operator()(const f32x4 (&acc)[2][2][4][2], const Unit& u, int wr, int wc, int fr, int fq, int ui) const {
        const int row0 = u.pm * BM + wr * 64 + fr;
        float rsv[8];
#pragma unroll
        for (int rg = 0; rg < 8; ++rg) rsv[rg] = rt[(one_pm ? 0 : ui) * BM + wr * 64 + fr + (rg >> 2) * HALF + (rg & 3) * 16];
#pragma unroll
        for (int ai = 0; ai < 2; ++ai)
#pragma unroll
            for (int m = 0; m < 4; ++m) {
                const int row = row0 + ai * HALF + m * 16;
                const float rs = rsv[ai * 4 + m];
                bf16_t* zp = Z + (size_t)row * NZ + u.pn * BM + wc * 32 + fq * 8;
#pragma unroll
                for (int bj = 0; bj < 2; ++bj) {
                    f32x4 a = acc[ai][bj][m][0] * rs, b = acc[ai][bj][m][1] * rs;
                    if (u.pn >= ZC_SG / BM) {
#pragma unroll
                        for (int e = 0; e < 4; ++e) { a[e] = sigmoidf_(a[e]); b[e] = sigmoidf_(b[e]); } }
                    *(u32x4*)(zp + bj * HALF) = pack8(a, b);
                }
                asm volatile("" ::: "memory");
            }
    }
};
struct EpiBranch {
    static constexpr bool PERM = true;
    bf16_t* Y; const bf16_t* Zg; int first;
    __device__ __forceinline__ void operator()(const f32x4 (&acc)[2][2][4][2], const Unit& u, int wr, int wc, int fr, int fq, int ui) const {
        const int row0 = u.pm * BM + wr * 64 + fr, col0 = u.pn * BM + wc * 32 + fq * 8;
#pragma unroll
        for (int ai = 0; ai < 2; ++ai) {
            u32x4 g[4][2], y[4][2];
#pragma unroll
            for (int m = 0; m < 4; ++m)
#pragma unroll
                for (int bj = 0; bj < 2; ++bj) g[m][bj] = __builtin_nontemporal_load((const u32x4*)(Zg + (size_t)(row0 + ai * HALF + m * 16) * NZ + col0 + bj * HALF));
            if (!first) {
#pragma unroll
                for (int m = 0; m < 4; ++m)
#pragma unroll
                    for (int bj = 0; bj < 2; ++bj) y[m][bj] = *(const u32x4*)(Y + (size_t)(row0 + ai * HALF + m * 16) * D + col0 + bj * HALF);
            }
#pragma unroll
            for (int m = 0; m < 4; ++m)
#pragma unroll
                for (int bj = 0; bj < 2; ++bj) {
                    const u32x4 gg = g[m][bj];
                    f32x4 a = acc[ai][bj][m][0], b = acc[ai][bj][m][1];
                    a[0] *= bf_lo(gg.x); a[1] *= bf_hi(gg.x); a[2] *= bf_lo(gg.y); a[3] *= bf_hi(gg.y);
                    b[0] *= bf_lo(gg.z); b[1] *= bf_hi(gg.z); b[2] *= bf_lo(gg.w); b[3] *= bf_hi(gg.w);
                    if (!first) { const u32x4 yy = y[m][bj];
                        a[0] += bf_lo(yy.x); a[1] += bf_hi(yy.x); a[2] += bf_lo(yy.y); a[3] += bf_hi(yy.y);
                        b[0] += bf_lo(yy.z); b[1] += bf_hi(yy.z); b[2] += bf_lo(yy.w); b[3] += bf_hi(yy.w); }
                    *(u32x4*)(Y + (size_t)(row0 + ai * HALF + m * 16) * D + col0 + bj * HALF) = pack8(a, b);
                }
            asm volatile("" ::: "memory");
        }
    }
};
struct EpiResid {
    static constexpr bool PERM = true;
    const bf16_t* base; float* out; bf16_t* xb; float* ssq; unsigned char* xb8; int ldx = D;
    __device__ __forceinline__ void operator()(const f32x4 (&acc)[2][2][4][2], const Unit& u, int wr, int wc, int fr, int fq, int ui) const {
        const int row0 = u.pm * BM + wr * 64 + fr, col0 = u.pn * BM + wc * 32 + fq * 8;
#pragma unroll
        for (int ai = 0; ai < 2; ++ai) {
            u32x4 bs[4][2];
#pragma unroll
            for (int m = 0; m < 4; ++m)
#pragma unroll
                for (int bj = 0; bj < 2; ++bj) bs[m][bj] = *(const u32x4*)(base + (size_t)(row0 + ai * HALF + m * 16) * D + col0 + bj * HALF);
#pragma unroll
            for (int m = 0; m < 4; ++m) {
                const int row = row0 + ai * HALF + m * 16; float ss = 0.f;
#pragma unroll
                for (int bj = 0; bj < 2; ++bj) {
                    const size_t o = (size_t)row * D + col0 + bj * HALF;
                    const u32x4 r = bs[m][bj];
                    f32x4 a = acc[ai][bj][m][0], b = acc[ai][bj][m][1];
                    a[0] += bf_lo(r.x); a[1] += bf_hi(r.x); a[2] += bf_lo(r.y); a[3] += bf_hi(r.y);
                    b[0] += bf_lo(r.z); b[1] += bf_hi(r.z); b[2] += bf_lo(r.w); b[3] += bf_hi(r.w);
                    if (out) { *(f32x4*)(out + o) = a; *(f32x4*)(out + o + 4) = b; }
                    *(u32x4*)(xb + (size_t)row * ldx + col0 + bj * HALF) = pack8(a, b);
                    if (xb8 && row < TG) { u32x2 w8; w8.x = cvt_pk4_fp8(a[0] * ACT8_SCALE, a[1] * ACT8_SCALE, a[2] * ACT8_SCALE, a[3] * ACT8_SCALE); w8.y = cvt_pk4_fp8(b[0] * ACT8_SCALE, b[1] * ACT8_SCALE, b[2] * ACT8_SCALE, b[3] * ACT8_SCALE); *(u32x2*)(xb8 + o) = w8; }
                    ss += ((a[0] * a[0] + a[1] * a[1]) + (a[2] * a[2] + a[3] * a[3])) + ((b[0] * b[0] + b[1] * b[1]) + (b[2] * b[2] + b[3] * b[3]));
                }
                ss += __shfl_xor(ss, 16); ss += __shfl_xor(ss, 32);
                if (fq == 0) ssq[(size_t)row * 16 + u.pn * 4 + wc] = ss;
            }
            asm volatile("" ::: "memory");
        }
    }
};
template <bool F8OUT> struct EpiSwiglu {
    static constexpr bool PERM = true;
    unsigned char* out; int ldo; const float* rsrc; const LAS float* rtl;
    __device__ __forceinline__ void operator()(const f32x4 (&acc)[2][2][4][2], const Unit& u, int wr, int wc, int fr, int fq, int ui) const {
        const int row0 = u.pm * BM + wr * 64 + fr, col = u.pn * HALF + wc * 32 + fq * 8;
        float rsv[8];
#pragma unroll
        for (int rg = 0; rg < 8; ++rg) { if constexpr (F8OUT) rsv[rg] = 1.0f; else rsv[rg] = rtl[ui * BM + wr * 64 + fr + (rg >> 2) * HALF + (rg & 3) * 16]; }
#pragma unroll
        for (int ai = 0; ai < 2; ++ai)
#pragma unroll
            for (int m = 0; m < 4; ++m) {
                const int row = row0 + ai * HALF + m * 16;
                const float rs = rsv[ai * 4 + m];
                f32x4 a, b;
#pragma unroll
                for (int e = 0; e < 4; ++e) { a[e] = siluf_(acc[ai][0][m][0][e] * rs) * (acc[ai][1][m][0][e] * rs); b[e] = siluf_(acc[ai][0][m][1][e] * rs) * (acc[ai][1][m][1][e] * rs); }
                if constexpr (F8OUT) { u32x2 w8; w8.x = cvt_pk4_fp8(a[0] * ACT8_SCALE, a[1] * ACT8_SCALE, a[2] * ACT8_SCALE, a[3] * ACT8_SCALE); w8.y = cvt_pk4_fp8(b[0] * ACT8_SCALE, b[1] * ACT8_SCALE, b[2] * ACT8_SCALE, b[3] * ACT8_SCALE); *(u32x2*)(out + (size_t)row * ldo + col) = w8; }
                else *(u32x4*)(out + ((size_t)row * ldo + col) * 2) = pack8(a, b);
                asm volatile("" ::: "memory");
            }
    }
};
struct EpiMoeDown {
    static constexpr bool PERM = true;
    bf16_t* YD; int first;
    __device__ __forceinline__ void operator()(const f32x4 (&acc)[2][2][4][2], const Unit& u, int wr, int wc, int fr, int fq, int ui) const {
        const int row0 = u.pm * BM + wr * 64 + fr, col0 = u.pn * BM + wc * 32 + fq * 8;
#pragma unroll
        for (int ai = 0; ai < 2; ++ai)
#pragma unroll
            for (int m = 0; m < 4; ++m) {
                const int row = row0 + ai * HALF + m * 16;
#pragma unroll
                for (int bj = 0; bj < 2; ++bj) {
                    bf16_t* yp = YD + (size_t)row * D + col0 + bj * HALF;
                    f32x4 a = acc[ai][bj][m][0], b = acc[ai][bj][m][1];
                    if (!first) { const u32x4 y = *(const u32x4*)yp;
                        a[0] += bf_lo(y.x); a[1] += bf_hi(y.x); a[2] += bf_lo(y.y); a[3] += bf_hi(y.y);
                        b[0] += bf_lo(y.z); b[1] += bf_hi(y.z); b[2] += bf_lo(y.w); b[3] += bf_hi(y.w); }
                    *(u32x4*)yp = pack8(a, b);
                }
                asm volatile("" ::: "memory");
            }
    }
};
}
constexpr size_t MiB = 1u << 20;
constexpr size_t WS_CTL = 0, CTL_ZERO_BYTES = 1 * MiB;
constexpr size_t WS_ROPE = 1 * MiB;
constexpr size_t WS_SSQ = 2 * MiB;
constexpr size_t WS_GATES = 4 * MiB;
constexpr size_t WS_MSC = 4 * MiB + 512 * 1024;
constexpr size_t WS_MNV = 4 * MiB + 576 * 1024;
constexpr size_t WS_TOKE = 5 * MiB;
constexpr size_t WS_TOKP = 5 * MiB + 128 * 1024;
constexpr size_t WS_TOKR = 5 * MiB + 256 * 1024;
constexpr size_t WS_TOKS = 5 * MiB + 384 * 1024;
constexpr size_t WS_ELIST = 6 * MiB;
constexpr size_t WS_TS = 7 * MiB;
constexpr size_t WS_SLOTRS = 7 * MiB + 4096;
constexpr size_t WS_RTAB = 566 * MiB;
constexpr size_t WS_WSMALL = 8 * MiB;
constexpr size_t WS_WIN = WS_WSMALL;
constexpr size_t WS_WBR = WS_WIN + 2 * (size_t)NZ * D * 2;
constexpr size_t WS_WOUT = WS_WBR + 2 * (size_t)D * OW * 2;
constexpr size_t WS_WUP = WS_WOUT + 2 * (size_t)D * D * 2;
constexpr size_t WS_WDN = WS_WUP + (size_t)2 * FF * D * 2;
constexpr size_t WS_Z = 70 * MiB;
constexpr size_t WS_O = 358 * MiB;
constexpr size_t WS_Y = 398 * MiB;
constexpr size_t WS_XB = 430 * MiB;
constexpr size_t WS_VT = 494 * MiB;
constexpr size_t WS_RU = 518 * MiB;
constexpr size_t WS_MU = 550 * MiB;
constexpr size_t WS_NEED = 582 * MiB;
constexpr size_t WS_XB8G = 566 * MiB;
constexpr size_t WS_A1 = WS_Z;
constexpr size_t WS_XB8 = WS_Z + 96 * MiB;
constexpr size_t WS_WMOE = 8 * MiB;
constexpr size_t WMOE_UP_BYTES = (size_t)2 * FFE * D, WMOE_E_BYTES = WMOE_UP_BYTES + (size_t)D * FFE;
constexpr size_t WS_XG = 92 * MiB;
constexpr size_t WS_YD = 158 * MiB;
constexpr size_t WS_AE = 290 * MiB;
static_assert(WS_WDN + (size_t)D * FF * 2 <= WS_Z && WS_Z + (size_t)TG * NZ * 2 <= WS_O && WS_O + (size_t)TG * OW * 2 <= WS_Y && WS_Y + (size_t)TG * D * 2 <= WS_XB, "ws map 1");
static_assert(WS_XB + (size_t)T * D * 2 <= WS_VT && WS_VT + (size_t)BG * 12 * 64 * SEQ * 2 <= WS_RU && WS_RU + (size_t)512 * 16384 * 4 <= WS_MU && WS_MU + (size_t)512 * 8192 * 4 <= WS_NEED, "ws map 2");
static_assert(WS_WMOE + NE * WMOE_E_BYTES <= WS_XG && WS_XG + (size_t)MAXSLOT * D <= WS_YD && WS_YD + (size_t)MAXSLOT * D * 2 <= WS_AE && WS_AE + (size_t)MAXSLOT * FFE <= WS_NEED, "ws map 3");
static_assert(WS_A1 + (size_t)T * FF * 2 <= WS_O, "ws map 4");
constexpr int CW_CNT = 64;
constexpr int CW_BAR = 4096;
constexpr int RING_BYTES = 131072, MISC_OFF = RING_BYTES, LDS_BYTES = 147456;
constexpr unsigned long long tl6(int a, int b, int c, int d, int e, int f, int g, int h, int i, int j) { return (unsigned long long)a | ((unsigned long long)b << 6) | ((unsigned long long)c << 12) | ((unsigned long long)d << 18) | ((unsigned long long)e << 24) | ((unsigned long long)f << 30) | ((unsigned long long)g << 36) | ((unsigned long long)h << 42) | ((unsigned long long)i << 48) | ((unsigned long long)j << 54); }
constexpr unsigned long long TL16_LO = tl6(0, 1, 2, 3, 4, 5, 6, 8, 9, 10), TL16_HI = tl6(11, 12, 13, 17, 18, 23, 0, 0, 0, 0);
constexpr unsigned long long TL20_LO = tl6(7, 14, 15, 16, 19, 20, 21, 22, 24, 25), TL20_HI = tl6(26, 27, 28, 29, 30, 31, 32, 33, 34, 35);
constexpr int RTAB_UNITS = 20;
constexpr int NPHASES = 32;

#define XB_TMO      128
#define XB_XCNT(j)  (256  + 64 * (j))
#define XB_XSUB(j)  (1280 + 64 * (j))
#define XB_XGEN(j)  (2304 + 64 * (j))
#define XB_TOP      3328
#define XB_TOPGEN   3392
#define XCD_BAR_WORDS 3456
#define XB_SPIN_CAP (1u << 18)
__device__ __forceinline__ unsigned xb_ld(unsigned* p)              { return __hip_atomic_load(p, __ATOMIC_RELAXED, __HIP_MEMORY_SCOPE_AGENT); }
__device__ __forceinline__ unsigned xb_add(unsigned* p, unsigned v) { return __hip_atomic_fetch_add(p, v, __ATOMIC_RELAXED, __HIP_MEMORY_SCOPE_AGENT); }
__device__ __forceinline__ unsigned xb_xcc_id() { return (unsigned)__builtin_amdgcn_s_getreg((3 << 11) | 20) & 0xFu; }
#define XB_SPIN(cond, bar) do { unsigned _sp = 0; while (cond) { __builtin_amdgcn_s_sleep(1); \
    if ((++_sp & 255u) == 0u) { if (xb_ld(&(bar)[XB_TMO])) break; if (_sp > XB_SPIN_CAP) { atomicAdd(&(bar)[XB_TMO], 1u); break; } } } } while (0)
struct XcdBarrier { unsigned* bar; unsigned x; volatile LAS unsigned* st; };
__device__ __forceinline__ XcdBarrier xcd_barrier_post(unsigned* bar, volatile LAS unsigned* st) {
    XcdBarrier b; b.bar = bar; b.x = xb_xcc_id(); b.st = st;
    if (threadIdx.x == 0) st[4] = xb_add(&bar[XB_XCNT(b.x)], 1u);
    return b;
}
__device__ __forceinline__ void xcd_barrier_complete(unsigned* bar, unsigned x, unsigned& nloc, unsigned& nx, unsigned& even) {
    const unsigned G = gridDim.x * gridDim.y * gridDim.z;
    unsigned sum, cnt, mine, ev, sp = 0u;
    for (;;) {
        sum = 0u; cnt = 0u; mine = 0u; ev = 1u;
#pragma unroll 1
        for (unsigned j = 0; j < 16; ++j) { const unsigned c = xb_ld(&bar[XB_XCNT(j)]); sum += c; cnt += (c > 0u) ? 1u : 0u; mine = (j == x) ? c : mine; ev &= (c == ((j < 8u) ? (G >> 3) : 0u)) ? 1u : 0u; }
        if (sum == G) break;
        __builtin_amdgcn_s_sleep(1);
        if ((++sp & 255u) == 0u) { if (xb_ld(&bar[XB_TMO])) break; if (sp > XB_SPIN_CAP) { atomicAdd(&bar[XB_TMO], 1u); break; } }
    }
    nloc = mine > 0u ? mine : 1u; nx = cnt > 0u ? cnt : 1u; even = (sum == G && (G & 7u) == 0u) ? ev : 0u;
}
__device__ __forceinline__ void xcd_barrier(const XcdBarrier& b) {
    asm volatile("s_waitcnt vmcnt(0)" ::: "memory");
    __syncthreads();
    if (threadIdx.x == 0) {
        unsigned* bar = b.bar;
        __builtin_amdgcn_s_waitcnt(0);
        unsigned nloc = b.st[0], nx = b.st[1];
        if (nloc == 0u) { unsigned even; xcd_barrier_complete(bar, b.x, nloc, nx, even); b.st[0] = nloc; b.st[1] = nx; b.st[2] = even; }
        const unsigned old = xb_add(&bar[XB_XSUB(b.x)], 1u);
        const unsigned gen = old / nloc;
        if (old + 1u == (gen + 1u) * nloc) {
            __builtin_amdgcn_fence(__ATOMIC_RELEASE, "agent");
            asm volatile("s_waitcnt vmcnt(0)" ::: "memory");
            const unsigned og = xb_add(&bar[XB_TOP], 1u);
            const unsigned tg = og / nx;
            if (og + 1u == (tg + 1u) * nx) xb_add(&bar[XB_TOPGEN], 1u);
            else XB_SPIN(xb_ld(&bar[XB_TOPGEN]) == tg, bar);
            __builtin_amdgcn_fence(__ATOMIC_ACQUIRE, "agent");
            xb_add(&bar[XB_XGEN(b.x)], 1u);
            asm volatile("s_waitcnt vmcnt(0)" ::: "memory");
        } else {
            XB_SPIN(xb_ld(&bar[XB_XGEN(b.x)]) == gen, bar);
            __builtin_amdgcn_fence(__ATOMIC_ACQUIRE, "agent");
            asm volatile("s_waitcnt vmcnt(0)" ::: "memory");
        }
    }
    __syncthreads();
}

#define XL_CNT(j) (8192 + 64 * (j))
__device__ __forceinline__ void xcd_local_barrier(unsigned* bar, unsigned x, unsigned nloc) {
    asm volatile("s_waitcnt vmcnt(0)" ::: "memory");
    __syncthreads();
    if (threadIdx.x == 0) {
        __builtin_amdgcn_s_waitcnt(0);
        const unsigned old = xb_add(&bar[XL_CNT(x)], 1u);
        const unsigned target = (old / nloc + 1u) * nloc;
        XB_SPIN(xb_ld(&bar[XL_CNT(x)]) < target, bar);
        __builtin_amdgcn_fence(__ATOMIC_ACQUIRE, "agent");
        asm volatile("s_waitcnt vmcnt(0)" ::: "memory");
    }
    __syncthreads();
}

struct Frame {
    LAS unsigned char* lds;
    unsigned char* ws;
    int tid, lane, wave, G, gw, NGW;
};
__device__ __forceinline__ float wave_sum(float v) {
#pragma unroll
    for (int o = 1; o < 64; o <<= 1) v += __shfl_xor(v, o);
    return v;
}
__device__ __forceinline__ float wave_max(float v) {
#pragma unroll
    for (int o = 1; o < 64; o <<= 1) v = fmaxf(v, __shfl_xor(v, o));
    return v;
}
__device__ __forceinline__ bf16x8 as_bf16x8(u32x4 v) { return __builtin_bit_cast(bf16x8, v); }
__device__ __forceinline__ f32x4 mfma16(bf16x8 a, bf16x8 b, f32x4 c) { return __builtin_amdgcn_mfma_f32_16x16x32_bf16(a, b, c, 0, 0, 0); }
__device__ __forceinline__ bf16x8 rowfrag(const LAS unsigned char* img, int rs, int row, int colbyte) { return *(const LAS bf16x8*)(img + row * rs + colbyte); }
__device__ __forceinline__ bf16x8 trfrag(const LAS unsigned char* img, int rs, int r0, int c0, int lane, int gs, int ts) {
    const int g = lane >> 4, q = (lane & 15) >> 2, p = lane & 3;
    const LAS unsigned char* a0 = img + (r0 + g * gs + q) * rs + (c0 + 4 * p) * 2;
    const s16x4 v0 = __builtin_amdgcn_ds_read_tr16_b64_v4i16((LAS s16x4*)a0);
    const s16x4 v1 = __builtin_amdgcn_ds_read_tr16_b64_v4i16((LAS s16x4*)(a0 + ts * rs));
    return (bf16x8){v0[0], v0[1], v0[2], v0[3], v1[0], v1[1], v1[2], v1[3]};
}
#define TR_NAT(img, rs, r0, c0, lane) trfrag(img, rs, r0, c0, lane, 8, 4)
#define TR_PERM(img, rs, r0, c0, lane) trfrag(img, rs, r0, c0, lane, 4, 16)

template <class M> __device__ __forceinline__ int dst_row(const M&, int n) { return n; }
template <bool F8, class Map>
__device__ __forceinline__ void convert_w(const Frame& F, int& woff, int ldw, int K, int N, void* dstv, int ldd, int kofs, const float* rowscale, const Map map) {
    const int nblk = N / 64, nitems = (K / 64) * nblk, lane = F.lane;
    int first = F.gw - woff; first += first < 0 ? F.NGW : 0; woff = (woff + nitems) % F.NGW;
    for (int item = first; item < nitems; item += F.NGW) {
        const int kb = item / nblk, nb = item % nblk, k0 = 64 * kb, n = 64 * nb + lane;
        const float* p; float s; map(n, p, s); const int dn = dst_row(map, n);
        float v[64];
        if (p) { const float* q = p + (size_t)k0 * ldw;
#pragma unroll
            for (int i = 0; i < 64; ++i) v[i] = __builtin_nontemporal_load(q + (size_t)i * ldw);
        } else {
#pragma unroll
            for (int i = 0; i < 64; ++i) v[i] = 0.f;
        }
        if (rowscale) {
#pragma unroll
            for (int i = 0; i < 64; ++i) v[i] *= rowscale[k0 + i] * s;
        } else {
#pragma unroll
            for (int i = 0; i < 64; ++i) v[i] *= s;
        }
        if constexpr (F8) {
            unsigned char* o = (unsigned char*)dstv + (size_t)dn * ldd + kofs + k0;
#pragma unroll
            for (int c16 = 0; c16 < 4; ++c16) { u32x4 w;
                w.x = cvt_pk4_fp8(v[16 * c16] * W8_SCALE, v[16 * c16 + 1] * W8_SCALE, v[16 * c16 + 2] * W8_SCALE, v[16 * c16 + 3] * W8_SCALE);
                w.y = cvt_pk4_fp8(v[16 * c16 + 4] * W8_SCALE, v[16 * c16 + 5] * W8_SCALE, v[16 * c16 + 6] * W8_SCALE, v[16 * c16 + 7] * W8_SCALE);
                w.z = cvt_pk4_fp8(v[16 * c16 + 8] * W8_SCALE, v[16 * c16 + 9] * W8_SCALE, v[16 * c16 + 10] * W8_SCALE, v[16 * c16 + 11] * W8_SCALE);
                w.w = cvt_pk4_fp8(v[16 * c16 + 12] * W8_SCALE, v[16 * c16 + 13] * W8_SCALE, v[16 * c16 + 14] * W8_SCALE, v[16 * c16 + 15] * W8_SCALE);
                *(u32x4*)(o + 16 * c16) = w; }
        } else {
        bf16_t* o = (bf16_t*)dstv + (size_t)dn * ldd + kofs + k0;
#pragma unroll
        for (int c8 = 0; c8 < 8; ++c8) { u32x4 w; w.x = cvt_pk_bf16(v[8 * c8], v[8 * c8 + 1]); w.y = cvt_pk_bf16(v[8 * c8 + 2], v[8 * c8 + 3]); w.z = cvt_pk_bf16(v[8 * c8 + 4], v[8 * c8 + 5]); w.w = cvt_pk_bf16(v[8 * c8 + 6], v[8 * c8 + 7]);
            *(u32x4*)(o + 8 * c8) = w; }
        }
    }
}
struct MapIdent { const float* W; __device__ __forceinline__ void operator()(int n, const float*& p, float& s) const { p = W + n; s = 1.f; } };
struct MapWin { const float* W;
    __device__ __forceinline__ void operator()(int n, const float*& p, float& s) const {
        int src; s = 1.f;
        if (n < 1024) { const int seg = n >> 9, h = (n & 511) >> 7, jp = n & 127; src = seg * 512 + h * 128 + (jp >> 1) + 64 * (jp & 1); if (seg) s = 0.08838834764831845f; }
        else if (n >= 2048 && n < 3584) { const int nl = n - 2048, seg = nl / 768, nl2 = nl % 768, t = nl2 >> 8, c = nl2 & 255, bj = c >> 7, wc = (c & 127) >> 5, j = c & 31; src = 2048 + seg * 768 + (4 * t + wc) * 64 + 32 * bj + j; }
        else if (n < 5888) src = n;
        else if (n < 6144) src = (n - 5888 < 8) ? n : -1;
        else src = n - 248;
        p = src >= 0 ? W + src : nullptr;
    } };
struct MapWinGate { const float* W; __device__ __forceinline__ void operator()(int n, const float*& p, float& s) const { p = W + (6144 - 248) + n; s = 1.f; } };
struct MapWinSel { const float* W; unsigned long long lo, hi;
    __device__ __forceinline__ int row(int n) const { const int k = n >> 8; const unsigned long long w = k < 10 ? lo : hi; return (int)((w >> (6 * (k < 10 ? k : k - 10))) & 63ull) * 256 + (n & 255); }
    __device__ __forceinline__ void operator()(int n, const float*& p, float& s) const { MapWin{W}(row(n), p, s); } };
__device__ __forceinline__ int dst_row(const MapWinSel& m, int n) { return m.row(n); }
struct MapGateUp { const float* Wg; const float* Wu;
    __device__ __forceinline__ void operator()(int n, const float*& p, float& s) const { const int pn = n >> 8, c = n & 255; p = Wg + (ptrdiff_t)(c >> 7) * (Wu - Wg) + pn * 128 + (c & 127); s = 1.f; } };

__device__ __forceinline__ void p0_rows(const Frame& F, const float* x) {
    bf16_t* xb = (bf16_t*)(F.ws + WS_XB); float* ssq = (float*)(F.ws + WS_SSQ);
    for (int m0 = F.gw; m0 < T; m0 += 4 * F.NGW) {
        f32x4 v[4][4];
#pragma unroll
        for (int q = 0; q < 4; ++q) { const int m = m0 + q * F.NGW < T ? m0 + q * F.NGW : m0; const f32x4* xr = (const f32x4*)(x + (size_t)m * D) + F.lane;
#pragma unroll
            for (int j = 0; j < 4; ++j) v[q][j] = __builtin_nontemporal_load(xr + 64 * j); }
#pragma unroll
        for (int q = 0; q < 4; ++q) { const int m = m0 + q * F.NGW; if (m >= T) break;
            float s = 0.f;
#pragma unroll
            for (int j = 0; j < 4; ++j) s += (v[q][j][0] * v[q][j][0] + v[q][j][1] * v[q][j][1]) + (v[q][j][2] * v[q][j][2] + v[q][j][3] * v[q][j][3]);
            s = wave_sum(s);
            u32x2* o8 = (u32x2*)(xb + (size_t)m * D) + F.lane;
#pragma unroll
            for (int j = 0; j < 4; ++j) { u32x2 w; w.x = cvt_pk_bf16(v[q][j][0], v[q][j][1]); w.y = cvt_pk_bf16(v[q][j][2], v[q][j][3]); o8[64 * j] = w; }
            if (F.lane < 16) ssq[(size_t)m * 16 + F.lane] = F.lane == 0 ? s : 0.f;
            if (m < TG) { unsigned* o4 = (unsigned*)(F.ws + WS_XB8G + (size_t)m * D) + F.lane;
#pragma unroll
                for (int j = 0; j < 4; ++j) o4[64 * j] = cvt_pk4_fp8(v[q][j][0] * ACT8_SCALE, v[q][j][1] * ACT8_SCALE, v[q][j][2] * ACT8_SCALE, v[q][j][3] * ACT8_SCALE); }
        }
    }
}
__device__ __forceinline__ void p0_rope(const Frame& F) {
    float* rope = (float*)(F.ws + WS_ROPE);
    for (int i = F.gw * 64 + F.lane; i < SEQ * 64; i += F.NGW * 64) {
        const int pos = i >> 6, k = i & 63;
        const float inv = powf(10000.0f, -(float)k / 64.0f);
        const float ang = (float)pos * inv;
        double rev = (double)ang * 0.15915494309189535; rev -= floor(rev);
        rope[i] = __builtin_amdgcn_cosf((float)rev); rope[SEQ * 64 + i] = __builtin_amdgcn_sinf((float)rev);
    }
}
constexpr int RS128 = 272, RS64 = 144;
struct LayerP {
    const float *ret_norm_w, *da_qw, *da_kw, *conv_w, *i_bias, *f_bias, *ml_norm_w;
};
__device__ __forceinline__ float ret_log2gamma(int h) { return log2f(1.0f - exp2f(-5.0f - (float)h)); }

template <int NC>
__device__ __forceinline__ void load_tile(const Frame& F, const bf16_t* g, int ldg, LAS unsigned char* img, int rs) {
    constexpr int PPR = NC / 8, NP = 128 * PPR;
    u32x4 t[NP / 512];
#pragma unroll
    for (int i = 0; i < NP / 512; ++i) { const int pc = F.tid + 512 * i, r = pc / PPR, ch = pc % PPR; t[i] = *(const u32x4*)(g + (size_t)r * ldg + ch * 8); }
#pragma unroll
    for (int i = 0; i < NP / 512; ++i) { const int pc = F.tid + 512 * i, r = pc / PPR, ch = pc % PPR; *(LAS u32x4*)(img + r * rs + ch * 16) = t[i]; }
}
template <int NC>
__device__ __forceinline__ void load_tile_scaled(const Frame& F, const bf16_t* g, int ldg, LAS unsigned char* img, int rs, const LAS float* sc) {
    constexpr int PPR = NC / 8, NP = 128 * PPR;
    u32x4 t[NP / 512];
#pragma unroll
    for (int i = 0; i < NP / 512; ++i) { const int pc = F.tid + 512 * i, r = pc / PPR, ch = pc % PPR; t[i] = *(const u32x4*)(g + (size_t)r * ldg + ch * 8); }
#pragma unroll
    for (int i = 0; i < NP / 512; ++i) { const int pc = F.tid + 512 * i, r = pc / PPR, ch = pc % PPR;
        const u32x4 v = t[i]; const float s = sc[r];
        u32x4 o; o.x = cvt_pk_bf16(bf_lo(v.x) * s, bf_hi(v.x) * s); o.y = cvt_pk_bf16(bf_lo(v.y) * s, bf_hi(v.y) * s); o.z = cvt_pk_bf16(bf_lo(v.z) * s, bf_hi(v.z) * s); o.w = cvt_pk_bf16(bf_lo(v.w) * s, bf_hi(v.w) * s);
        *(LAS u32x4*)(img + r * rs + ch * 16) = o; }
}
template <int NC>
__device__ __forceinline__ void load_tile_f32(const Frame& F, const float* g, LAS unsigned char* img, int rs) {
    constexpr int PPR = NC / 8, NP = 128 * PPR;
    f32x4 t[NP / 512][2];
#pragma unroll
    for (int i = 0; i < NP / 512; ++i) { const int pc = F.tid + 512 * i, r = pc / PPR, ch = pc % PPR; t[i][0] = *(const f32x4*)(g + (size_t)r * NC + ch * 8); t[i][1] = *(const f32x4*)(g + (size_t)r * NC + ch * 8 + 4); }
#pragma unroll
    for (int i = 0; i < NP / 512; ++i) { const int pc = F.tid + 512 * i, r = pc / PPR, ch = pc % PPR; *(LAS u32x4*)(img + r * rs + ch * 16) = pg8::pack8(t[i][0], t[i][1]); }
}
__device__ __forceinline__ u32x4 conv8(const bf16_t* Z, int row, int col, const float* cw, float scale) {
    const int pos = row & (SEQ - 1);
    float acc[8];
#pragma unroll
    for (int e = 0; e < 8; ++e) acc[e] = 0.f;
    u32x4 vv[4]; f32x4 ww[4][2];
#pragma unroll
    for (int i = 0; i < 4; ++i) { const int back = (pos - 3 + i >= 0) ? 3 - i : 0;
        vv[i] = *(const u32x4*)(Z + (size_t)(row - back) * NZ + col); ww[i][0] = *(const f32x4*)(cw + i * 512); ww[i][1] = *(const f32x4*)(cw + i * 512 + 4); }
#pragma unroll
    for (int i = 0; i < 4; ++i) {
        const float on = (pos - 3 + i >= 0) ? 1.0f : 0.0f;
        const u32x4 v = vv[i]; const f32x4 w0 = ww[i][0] * on, w1 = ww[i][1] * on;
        acc[0] += bf_lo(v.x) * w0[0]; acc[1] += bf_hi(v.x) * w0[1]; acc[2] += bf_lo(v.y) * w0[2]; acc[3] += bf_hi(v.y) * w0[3];
        acc[4] += bf_lo(v.z) * w1[0]; acc[5] += bf_hi(v.z) * w1[1]; acc[6] += bf_lo(v.w) * w1[2]; acc[7] += bf_hi(v.w) * w1[3];
    }
#pragma unroll
    for (int e = 0; e < 8; ++e) acc[e] = siluf_(acc[e]) * scale;
    u32x4 o; o.x = cvt_pk_bf16(acc[0], acc[1]); o.y = cvt_pk_bf16(acc[2], acc[3]); o.z = cvt_pk_bf16(acc[4], acc[5]); o.w = cvt_pk_bf16(acc[6], acc[7]);
    return o;
}

struct Conv8Rows { u32x4 v[4]; };
struct Conv8W { f32x4 w[4][2]; };
__device__ __forceinline__ Conv8Rows conv8_rows(const bf16_t* Z, int row, int col) {
    const int pos = row & (SEQ - 1); Conv8Rows r;
#pragma unroll
    for (int i = 0; i < 4; ++i) { const int back = (pos - 3 + i >= 0) ? 3 - i : 0; r.v[i] = *(const u32x4*)(Z + (size_t)(row - back) * NZ + col); }
    return r;
}
__device__ __forceinline__ Conv8W conv8_weights(const float* cw) { Conv8W w;
#pragma unroll
    for (int i = 0; i < 4; ++i) { w.w[i][0] = *(const f32x4*)(cw + i * 512); w.w[i][1] = *(const f32x4*)(cw + i * 512 + 4); }
    return w;
}
__device__ __forceinline__ u32x4 conv8_finish(const Conv8Rows& r, const Conv8W& w, int row, float scale) {
    const int pos = row & (SEQ - 1);
    float acc[8];
#pragma unroll
    for (int e = 0; e < 8; ++e) acc[e] = 0.f;
#pragma unroll
    for (int i = 0; i < 4; ++i) {
        const float on = (pos - 3 + i >= 0) ? 1.0f : 0.0f;
        const u32x4 v = r.v[i]; const f32x4 w0 = w.w[i][0] * on, w1 = w.w[i][1] * on;
        acc[0] += bf_lo(v.x) * w0[0]; acc[1] += bf_hi(v.x) * w0[1]; acc[2] += bf_lo(v.y) * w0[2]; acc[3] += bf_hi(v.y) * w0[3];
        acc[4] += bf_lo(v.z) * w1[0]; acc[5] += bf_hi(v.z) * w1[1]; acc[6] += bf_lo(v.w) * w1[2]; acc[7] += bf_hi(v.w) * w1[3];
    }
#pragma unroll
    for (int e = 0; e < 8; ++e) acc[e] = siluf_(acc[e]) * scale;
    u32x4 o; o.x = cvt_pk_bf16(acc[0], acc[1]); o.y = cvt_pk_bf16(acc[2], acc[3]); o.z = cvt_pk_bf16(acc[4], acc[5]); o.w = cvt_pk_bf16(acc[6], acc[7]);
    return o;
}

__device__ __forceinline__ void ret_A(const Frame& F, int unit) {
    const int bl = unit >> 6, h = (unit >> 4) & 3, n = unit & 15, row0 = bl * SEQ + n * 128;
    const bf16_t* Z = (const bf16_t*)(F.ws + WS_Z);
    LAS unsigned char* Kimg = F.lds; LAS unsigned char* Vimg = F.lds + 128 * RS128; LAS float* sc = (LAS float*)(F.lds + 2 * 128 * RS128);
    const float lg = ret_log2gamma(h);
    if (F.tid < 128) sc[F.tid] = exp2f(lg * (float)(127 - F.tid));
    __syncthreads();
    load_tile<128>(F, Z + (size_t)row0 * NZ + ZC_RK + h * 128, NZ, Kimg, RS128);
    load_tile_scaled<128>(F, Z + (size_t)row0 * NZ + ZC_RV + h * 128, NZ, Vimg, RS128, sc);
    __syncthreads();
    const int w = F.wave, lane = F.lane, fr = lane & 15, fq = lane >> 4;
    bf16x8 a[4];
#pragma unroll
    for (int ks = 0; ks < 4; ++ks) a[ks] = TR_NAT(Kimg, RS128, 32 * ks, 16 * w, lane);
    bf16_t* U = (bf16_t*)(F.ws + WS_RU) + (size_t)unit * 16384;
#pragma unroll
    for (int dvt = 0; dvt < 8; ++dvt) {
        f32x4 acc = {0.f, 0.f, 0.f, 0.f};
#pragma unroll
        for (int ks = 0; ks < 4; ++ks) acc = mfma16(a[ks], TR_NAT(Vimg, RS128, 32 * ks, 16 * dvt, lane), acc);
        { u32x2 o; o.x = cvt_pk_bf16(acc[0], acc[1]); o.y = cvt_pk_bf16(acc[2], acc[3]); *(u32x2*)(U + (16 * dvt + fr) * 128 + 16 * w + 4 * fq) = o; }
    }
    __syncthreads();
}
__device__ __forceinline__ void ml_gates(const Frame& F, const LayerP& P, int row0, int h, LAS float* ig, LAS float* bc, LAS float* lf) {
    const float* gates = (const float*)(F.ws + WS_GATES);
    float s = 0.f;
    if (F.tid < 128) {
        const float ip = gates[(size_t)(row0 + F.tid) * 8 + h] + P.i_bias[h];
        const float fp = gates[(size_t)(row0 + F.tid) * 8 + 4 + h] + P.f_bias[h];
        ig[F.tid] = ip; s = fminf(fp, 0.f) - log1pf(__expf(-fabsf(fp)));
#pragma unroll
        for (int o = 1; o < 64; o <<= 1) { const float t = __shfl_up(s, o); if (F.lane >= o) s += t; }
        if (F.tid == 63) lf[0] = s;
    }
    __syncthreads();
    if (F.tid < 128) bc[F.tid] = s + (F.tid >= 64 ? lf[0] : 0.f);
    __syncthreads();
}
__device__ __forceinline__ void ml_A(const Frame& F, const LayerP& P, int unit) {
    const int bl = unit >> 6, h = (unit >> 4) & 3, n = unit & 15, row0 = bl * SEQ + n * 128;
    const bf16_t* Z = (const bf16_t*)(F.ws + WS_Z);
    LAS unsigned char* Kimg = F.lds; LAS unsigned char* Vimg = F.lds + 128 * RS64;
    LAS float* ig = (LAS float*)(F.lds + 128 * RS64 + 128 * RS128); LAS float* bc = ig + 128; LAS float* wt = bc + 128; LAS float* red = wt + 128;
    const int kch = F.tid & 7;
    const Conv8W kw8 = conv8_weights(P.conv_w + 256 + h * 64 + kch * 8);
    Conv8Rows kr[2]; u32x4 vraw[4];
#pragma unroll
    for (int i = 0; i < 2; ++i) kr[i] = conv8_rows(Z, row0 + ((F.tid + 512 * i) >> 3), ZC_MK + h * 64 + kch * 8);
#pragma unroll
    for (int i = 0; i < 4; ++i) { const int pc = F.tid + 512 * i, r = pc >> 4, ch = pc & 15; vraw[i] = *(const u32x4*)(Z + (size_t)(row0 + r) * NZ + ZC_MV + h * 128 + ch * 8); }
    ml_gates(F, P, row0, h, ig, bc, wt);
    const float an = bc[127];
    if (F.tid < 64) { float v = fmaxf(an - bc[F.tid] + ig[F.tid], an - bc[F.tid + 64] + ig[F.tid + 64]); v = wave_max(v); if (F.tid == 0) red[0] = v; }
    __syncthreads();
    const float cn = red[0];
    if (F.tid < 128) wt[F.tid] = __expf(an - bc[F.tid] + ig[F.tid] - cn);
#pragma unroll
    for (int i = 0; i < 2; ++i) { const int pc = F.tid + 512 * i, r = pc >> 3;
        *(LAS u32x4*)(Kimg + r * RS64 + kch * 16) = conv8_finish(kr[i], kw8, row0 + r, 0.125f); }
    __syncthreads();
#pragma unroll
    for (int i = 0; i < 4; ++i) { const int pc = F.tid + 512 * i, r = pc >> 4, ch = pc & 15; const u32x4 v = vraw[i]; const float s = wt[r];
        u32x4 o; o.x = cvt_pk_bf16(bf_lo(v.x) * s, bf_hi(v.x) * s); o.y = cvt_pk_bf16(bf_lo(v.y) * s, bf_hi(v.y) * s); o.z = cvt_pk_bf16(bf_lo(v.z) * s, bf_hi(v.z) * s); o.w = cvt_pk_bf16(bf_lo(v.w) * s, bf_hi(v.w) * s);
        *(LAS u32x4*)(Vimg + r * RS128 + ch * 16) = o; }
    __syncthreads();
    const int w = F.wave, lane = F.lane, fr = lane & 15, fq = lane >> 4, dkt = w & 3;
    bf16x8 a[4];
#pragma unroll
    for (int ks = 0; ks < 4; ++ks) a[ks] = TR_NAT(Kimg, RS64, 32 * ks, 16 * dkt, lane);
    bf16_t* U = (bf16_t*)(F.ws + WS_MU) + (size_t)unit * 8192;
#pragma unroll
    for (int d4 = 0; d4 < 4; ++d4) { const int dvt = (w >> 2) * 4 + d4;
        f32x4 acc = {0.f, 0.f, 0.f, 0.f};
#pragma unroll
        for (int ks = 0; ks < 4; ++ks) acc = mfma16(a[ks], TR_NAT(Vimg, RS128, 32 * ks, 16 * dvt, lane), acc);
        { u32x2 o; o.x = cvt_pk_bf16(acc[0], acc[1]); o.y = cvt_pk_bf16(acc[2], acc[3]); *(u32x2*)(U + (16 * dvt + fr) * 64 + 16 * dkt + 4 * fq) = o; }
    }
    { const int dk = F.tid & 63, part = F.tid >> 6; float s = 0.f;
#pragma unroll
        for (int j = 0; j < 16; ++j) s += wt[part * 16 + j] * bf2f(*(const LAS bf16_t*)(Kimg + (part * 16 + j) * RS64 + dk * 2));
        red[64 + F.tid] = s; }
    __syncthreads();
    if (F.tid < 64) { float s = 0.f;
#pragma unroll
        for (int p = 0; p < 8; ++p) s += red[64 + p * 64 + F.tid];
        ((float*)(F.ws + WS_MNV))[(size_t)unit * 64 + F.tid] = s; }
    if (F.tid == 0) { float* msc = (float*)(F.ws + WS_MSC) + (size_t)unit * 4; msc[0] = an; msc[1] = cn; }
    __syncthreads();
}
__device__ __forceinline__ void vt_A(const Frame& F, int unit) {
    const int bl = unit / 96, head = (unit / 8) % 12, blk = unit & 7, r = head < 4 ? 1 : (head < 8 ? 4 : 16), rsh = head < 4 ? 0 : (head < 8 ? 2 : 4);
    const bf16_t* Z = (const bf16_t*)(F.ws + WS_Z);
    LAS unsigned char* img = F.lds;
    u32x4 tv[4];
#pragma unroll
    for (int i = 0; i < 4; ++i) { const int pc = F.tid + 512 * i, rr = pc >> 3, ch = pc & 7; tv[i] = *(const u32x4*)(Z + (size_t)(bl * SEQ + blk * 256 + rr) * NZ + ZC_DV + head * 64 + ch * 8); }
#pragma unroll
    for (int i = 0; i < 4; ++i) { const int pc = F.tid + 512 * i, rr = pc >> 3, ch = pc & 7; *(LAS u32x4*)(img + rr * RS64 + ch * 16) = tv[i]; }
    __syncthreads();
    bf16_t* VT = (bf16_t*)(F.ws + WS_VT) + (size_t)(bl * 12 + head) * 64 * SEQ;
    const int g4r = 64 >> rsh;
#pragma unroll
    for (int i = 0; i < 4; ++i) { const int pc = F.tid + 512 * i, pg = pc >> 5, d2 = pc & 31, rho = pg / g4r, p4 = pg % g4r;
        unsigned short v[8];
#pragma unroll
        for (int dd = 0; dd < 2; ++dd)
#pragma unroll
            for (int e = 0; e < 4; ++e) v[dd * 4 + e] = *(const LAS bf16_t*)(img + (((p4 * 4 + e) << rsh) + rho) * RS64 + (2 * d2 + dd) * 2);
        u32x4 o; o.x = v[0] | ((unsigned)v[1] << 16); o.y = v[2] | ((unsigned)v[3] << 16); o.z = v[4] | ((unsigned)v[5] << 16); o.w = v[6] | ((unsigned)v[7] << 16);
        const int pos4 = ((rho * (SEQ >> rsh) + ((blk * 256) >> rsh)) >> 2) + p4;
        *(u32x4*)(VT + ((size_t)pos4 * 64 + 2 * d2) * 4) = o; }
    __syncthreads();
}
__device__ __forceinline__ void scan_B(const Frame& F, int c) {
    const int gt = (c >> 3) * 512 + F.tid, NT = (F.G >> 3) * 512, bl = c & 7;
    for (int j = gt; j < 4 * 4096; j += NT) { const int h = j >> 12, idx = j & 4095, bh = bl * 4 + h;
        const float cd = exp2f(128.0f * ret_log2gamma(h));
        u32x2* p = (u32x2*)(F.ws + WS_RU) + (size_t)bh * 16 * 4096 + idx; f32x4 s = {0.f, 0.f, 0.f, 0.f};
        u32x2 u[16];
#pragma unroll
        for (int n = 0; n < 16; ++n) u[n] = p[(size_t)n * 4096];
#pragma unroll
        for (int n = 0; n < 16; ++n) { u32x2 o; o.x = cvt_pk_bf16(s[0], s[1]); o.y = cvt_pk_bf16(s[2], s[3]); p[(size_t)n * 4096] = o;
            const f32x4 uf = {bf_lo(u[n].x), bf_hi(u[n].x), bf_lo(u[n].y), bf_hi(u[n].y)}; s = s * cd + uf; } }
    for (int j = gt; j < 4 * 2064; j += NT) { const int bh = bl * 4 + j / 2064, idx = j % 2064;
        float* msc = (float*)(F.ws + WS_MSC) + (size_t)bh * 16 * 4;
        const bool isC = idx < 2048;
        u32x2* pb = (u32x2*)(F.ws + WS_MU) + (size_t)bh * 16 * 2048 + (isC ? idx : 0); f32x4* pf = (f32x4*)(F.ws + WS_MNV) + (size_t)bh * 16 * 16 + (isC ? 0 : idx - 2048);
        f32x4 s = {0.f, 0.f, 0.f, 0.f}; float mm = 0.f;
        f32x4 u[16]; float anv[16], cnv[16];
        if (isC) {
#pragma unroll
            for (int n = 0; n < 16; ++n) { const u32x2 r = pb[(size_t)n * 2048]; u[n] = (f32x4){bf_lo(r.x), bf_hi(r.x), bf_lo(r.y), bf_hi(r.y)}; }
        } else {
#pragma unroll
            for (int n = 0; n < 16; ++n) u[n] = pf[(size_t)n * 16];
        }
#pragma unroll
        for (int n = 0; n < 16; ++n) { anv[n] = msc[n * 4]; cnv[n] = msc[n * 4 + 1]; }
#pragma unroll
        for (int n = 0; n < 16; ++n) { const float an = anv[n], cn = cnv[n]; const float mn = fmaxf(an + mm, cn), f1 = __expf(an + mm - mn), f2 = __expf(cn - mn);
            if (isC) { u32x2 o; o.x = cvt_pk_bf16(s[0], s[1]); o.y = cvt_pk_bf16(s[2], s[3]); pb[(size_t)n * 2048] = o; } else pf[(size_t)n * 16] = s;
            s = s * f1 + u[n] * f2;
            if (idx == 0) msc[n * 4 + 2] = mm;
            mm = mn; } }
}
__device__ __forceinline__ void attn_B(const Frame& F, const LayerP& P, int unit) {
    const int bl = unit >> 5, j = (unit >> 3) & 3, blk = unit & 7;
    const bf16_t* Z = (const bf16_t*)(F.ws + WS_Z);
    LAS float* Oacc = (LAS float*)F.lds;
    LAS float* Lacc = Oacc + 256 * 68;
    const int w = F.wave, lane = F.lane, fr = lane & 15, fq = lane >> 4;
    const float shift = wave_max(fabsf(P.da_qw[lane] * P.da_kw[lane])) * 8.0f * LOG2E;
    for (int g = 0; g < 3; ++g) {
        const int head = 4 * g + j, rsh = 2 * g, r = 1 << rsh, Lr = SEQ >> rsh;
        const bf16_t* VT = (const bf16_t*)(F.ws + WS_VT) + (size_t)(bl * 12 + head) * 64 * SEQ;
        for (int it2 = 0; it2 < 2; ++it2) {
            const int it = w + 8 * it2, ipr = 16 >> rsh, rho = it / ipr, qt = it % ipr;
            const int i0 = ((blk * 256) >> rsh) + qt * 16;
            const int tq = ((i0 + fr) << rsh) + rho;
            const bf16_t* qp = Z + (size_t)(bl * SEQ + tq) * NZ + ZC_DQ + head * 64 + 8 * fq;
            const bf16x8 q0 = *(const bf16x8*)qp, q1 = *(const bf16x8*)(qp + 32);
            f32x4 o[4]; float lsum = 0.f;
#pragma unroll
            for (int dt = 0; dt < 4; ++dt) o[dt] = (f32x4){0.f, 0.f, 0.f, 0.f};
            const int kt_lo = i0 >= 128 ? 0 : (128 - i0) >> 4;
            const bf16_t* kbase = Z + (size_t)(bl * SEQ + rho) * NZ + ZC_DK + head * 64 + 8 * fq;
            bf16x8 kf[9][2];
#pragma unroll
            for (int kt = 0; kt < 9; ++kt) { int ik = i0 - 128 + 16 * kt + fr; ik = ik < 0 ? 0 : ik;
                const bf16_t* kp = kbase + (size_t)(ik << rsh) * NZ; kf[kt][0] = *(const bf16x8*)kp; kf[kt][1] = *(const bf16x8*)(kp + 32); }
            u32x2 vf[5][4][2];
#pragma unroll
            for (int ks = 0; ks < 5; ++ks) {
                int ik0 = i0 - 128 + 32 * ks + 4 * fq, ik1 = ik0 + 16;
                ik0 = ik0 < 0 ? 0 : ik0; ik1 = (ks == 4) ? ik0 : (ik1 < 0 ? 0 : ik1);
#pragma unroll
                for (int dt = 0; dt < 4; ++dt) { const bf16_t* vp = VT + (size_t)(16 * dt + fr) * 4;
                    vf[ks][dt][0] = *(const u32x2*)(vp + (size_t)((rho * Lr + ik0) >> 2) * 256); vf[ks][dt][1] = *(const u32x2*)(vp + (size_t)((rho * Lr + ik1) >> 2) * 256); }
            }
#pragma unroll
            for (int ks = 0; ks < 5; ++ks) {
                if (2 * ks + 1 < kt_lo) continue;
                u32x2 pp[2];
#pragma unroll
                for (int t = 0; t < 2; ++t) {
                    const int kt = 2 * ks + t;
                    float p[4] = {0.f, 0.f, 0.f, 0.f};
                    if (kt < 9) {
                        f32x4 s = {-shift, -shift, -shift, -shift};
                        s = mfma16(kf[kt < 9 ? kt : 8][0], q0, s); s = mfma16(kf[kt < 9 ? kt : 8][1], q1, s);
                        const bool tv = kt >= kt_lo;
#pragma unroll
                        for (int e = 0; e < 4; ++e) { const int kj = 16 * kt + 4 * fq + e;
                            const bool ok = tv && kj >= fr && kj <= 128 + fr;
                            p[e] = ok ? fast_exp2(s[e]) : 0.f; lsum += p[e]; }
                    }
                    pp[t].x = cvt_pk_bf16(p[0], p[1]); pp[t].y = cvt_pk_bf16(p[2], p[3]);
                }
                const bf16x8 pb = as_bf16x8((u32x4){pp[0].x, pp[0].y, pp[1].x, pp[1].y});
#pragma unroll
                for (int dt = 0; dt < 4; ++dt) o[dt] = mfma16(as_bf16x8((u32x4){vf[ks][dt][0].x, vf[ks][dt][0].y, vf[ks][dt][1].x, vf[ks][dt][1].y}), pb, o[dt]);
            }
            lsum += __shfl_xor(lsum, 16); lsum += __shfl_xor(lsum, 32);
            const int tl = tq - blk * 256;
#pragma unroll
            for (int dt = 0; dt < 4; ++dt) { LAS f32x4* op = (LAS f32x4*)(Oacc + tl * 68 + 16 * dt + 4 * fq); if (g == 0) *op = o[dt]; else *op = *op + o[dt]; }
            if (fq == 0) { if (g == 0) Lacc[tl] = lsum; else Lacc[tl] += lsum; }
        }
        __syncthreads();
    }
    bf16_t* O = (bf16_t*)(F.ws + WS_O);
#pragma unroll
    for (int i = 0; i < 4; ++i) { const int pc = F.tid + 512 * i, tl = pc >> 3, ch = pc & 7;
        const float inv = 1.0f / Lacc[tl];
        const f32x4 a = *(const LAS f32x4*)(Oacc + tl * 68 + ch * 8) * inv, b = *(const LAS f32x4*)(Oacc + tl * 68 + ch * 8 + 4) * inv;
        *(u32x4*)(O + (size_t)(bl * SEQ + blk * 256 + tl) * OW + OC_DA + j * 64 + ch * 8) = pg8::pack8(a, b); }
    __syncthreads();
}
__device__ __forceinline__ void ret_C(const Frame& F, const LayerP& P, int unit) {
    const int bl = unit >> 6, h = (unit >> 4) & 3, n = unit & 15, row0 = bl * SEQ + n * 128;
    const bf16_t* Z = (const bf16_t*)(F.ws + WS_Z);
    LAS unsigned char* Kimg = F.lds; LAS unsigned char* Vimg = F.lds + 128 * RS128; LAS unsigned char* Simg = F.lds + 2 * 128 * RS128;
    load_tile<128>(F, Z + (size_t)row0 * NZ + ZC_RK + h * 128, NZ, Kimg, RS128);
    load_tile<128>(F, Z + (size_t)row0 * NZ + ZC_RV + h * 128, NZ, Vimg, RS128);
    load_tile<128>(F, (const bf16_t*)(F.ws + WS_RU) + (size_t)unit * 16384, 128, Simg, RS128);
    const int w = F.wave, lane = F.lane, fr = lane & 15, fq = lane >> 4;
    const float lg = ret_log2gamma(h);
    const int qi = 16 * w + fr;
    const bf16_t* qp = Z + (size_t)(row0 + qi) * NZ + ZC_RQ + h * 128 + 8 * fq;
    bf16x8 qf[4];
#pragma unroll
    for (int ks = 0; ks < 4; ++ks) qf[ks] = *(const bf16x8*)(qp + 32 * ks);
    __syncthreads();
    f32x4 intra[8];
#pragma unroll
    for (int dvt = 0; dvt < 8; ++dvt) intra[dvt] = (f32x4){0.f, 0.f, 0.f, 0.f};
    for (int kp = 0; kp <= (w >> 1); ++kp) {
        u32x2 pp[2];
#pragma unroll
        for (int t = 0; t < 2; ++t) {
            const int kt = 2 * kp + t;
            f32x4 s = {0.f, 0.f, 0.f, 0.f};
            if (kt <= w) {
#pragma unroll
                for (int ks = 0; ks < 4; ++ks) s = mfma16(rowfrag(Kimg, RS128, 16 * kt + fr, (32 * ks + 8 * fq) * 2), qf[ks], s);
            }
            float p[4];
#pragma unroll
            for (int e = 0; e < 4; ++e) { const int kj = 16 * kt + 4 * fq + e; p[e] = (kj <= qi) ? s[e] * fast_exp2(lg * (float)(qi - kj)) : 0.f; }
            pp[t].x = cvt_pk_bf16(p[0], p[1]); pp[t].y = cvt_pk_bf16(p[2], p[3]);
        }
        const bf16x8 pb = as_bf16x8((u32x4){pp[0].x, pp[0].y, pp[1].x, pp[1].y});
#pragma unroll
        for (int dvt = 0; dvt < 8; ++dvt) intra[dvt] = mfma16(TR_PERM(Vimg, RS128, 32 * kp, 16 * dvt, lane), pb, intra[dvt]);
    }
    const float qdec = fast_exp2(lg * (float)(qi + 1));
    const bf16_t* gp = Z + (size_t)(row0 + qi) * NZ + ZC_RG + h * 128;
    f32x4 nwv[8]; u32x2 gvv[8];
#pragma unroll
    for (int dvt = 0; dvt < 8; ++dvt) { nwv[dvt] = *(const f32x4*)(P.ret_norm_w + h * 128 + 16 * dvt + 4 * fq); gvv[dvt] = *(const u32x2*)(gp + 16 * dvt + 4 * fq); }
    float ss = 0.f;
#pragma unroll
    for (int dvt = 0; dvt < 8; ++dvt) { f32x4 a = {0.f, 0.f, 0.f, 0.f};
#pragma unroll
        for (int ks = 0; ks < 4; ++ks) a = mfma16(rowfrag(Simg, RS128, 16 * dvt + fr, (32 * ks + 8 * fq) * 2), qf[ks], a);
        intra[dvt] = intra[dvt] + a * qdec; const f32x4 x = intra[dvt]; ss += (x[0] * x[0] + x[1] * x[1]) + (x[2] * x[2] + x[3] * x[3]); }
    ss += __shfl_xor(ss, 16); ss += __shfl_xor(ss, 32);
    const float hr = __builtin_amdgcn_rsqf(ss * (1.0f / 128.0f) + EPS);
    bf16_t* O = (bf16_t*)(F.ws + WS_O) + (size_t)(row0 + qi) * OW + OC_RET + h * 128;
#pragma unroll
    for (int dvt = 0; dvt < 8; ++dvt) { const int dv = 16 * dvt + 4 * fq;
        const f32x4 nw = nwv[dvt]; const u32x2 gv = gvv[dvt];
        const f32x4 x = intra[dvt] * hr * nw;
        u32x2 o; o.x = cvt_pk_bf16(x[0] * siluf_(bf_lo(gv.x)), x[1] * siluf_(bf_hi(gv.x))); o.y = cvt_pk_bf16(x[2] * siluf_(bf_lo(gv.y)), x[3] * siluf_(bf_hi(gv.y)));
        *(u32x2*)(O + dv) = o; }
    __syncthreads();
}
__device__ __forceinline__ void ml_C(const Frame& F, const LayerP& P, int unit) {
    const int bl = unit >> 6, h = (unit >> 4) & 3, n = unit & 15, row0 = bl * SEQ + n * 128;
    const bf16_t* Z = (const bf16_t*)(F.ws + WS_Z);
    LAS unsigned char* Kimg = F.lds; LAS unsigned char* Vimg = F.lds + 128 * RS64; LAS unsigned char* Cimg = Vimg + 128 * RS128;
    LAS float* ig = (LAS float*)(Cimg + 128 * RS64); LAS float* bc = ig + 128; LAS float* t0 = bc + 128;
    LAS float* clog = t0 + 128; LAS float* wi = clog + 128; LAS float* em = wi + 128; LAS float* nv = em + 128;
    const int kch = F.tid & 7;
    const Conv8W kw8 = conv8_weights(P.conv_w + 256 + h * 64 + kch * 8);
    Conv8Rows kr[2]; u32x4 vraw[4]; u32x4 craw[2];
#pragma unroll
    for (int i = 0; i < 2; ++i) kr[i] = conv8_rows(Z, row0 + ((F.tid + 512 * i) >> 3), ZC_MK + h * 64 + kch * 8);
#pragma unroll
    for (int i = 0; i < 4; ++i) { const int pc = F.tid + 512 * i, r = pc >> 4, ch = pc & 15; vraw[i] = *(const u32x4*)(Z + (size_t)(row0 + r) * NZ + ZC_MV + h * 128 + ch * 8); }
    { const bf16_t* cg = (const bf16_t*)(F.ws + WS_MU) + (size_t)unit * 8192;
#pragma unroll
        for (int i = 0; i < 2; ++i) { const int pc = F.tid + 512 * i, r = pc >> 3, ch = pc & 7; craw[i] = *(const u32x4*)(cg + (size_t)r * 64 + ch * 8); } }
    const float nvraw = (F.tid >= 128 && F.tid < 192) ? ((const float*)(F.ws + WS_MNV))[(size_t)unit * 64 + F.tid - 128] : 0.f;
    ml_gates(F, P, row0, h, ig, bc, t0);
    const float mm = ((const float*)(F.ws + WS_MSC))[(size_t)unit * 4 + 2];
    float pmv = -3.0e38f;
    if (F.tid < 128) { pmv = ig[F.tid] - bc[F.tid];
#pragma unroll
        for (int o = 1; o < 64; o <<= 1) { const float t = __shfl_up(pmv, o); if (F.lane >= o) pmv = fmaxf(pmv, t); }
        if (F.tid == 63) nv[0] = pmv; }
    __syncthreads();
    if (F.tid < 128) { const int i = F.tid; const float pm = (i >= 64) ? fmaxf(pmv, nv[0]) : pmv;
        const float mi = bc[i] + fmaxf(mm, pm);
        clog[i] = (ig[i] - bc[i]) * LOG2E; wi[i] = __expf(bc[i] + mm - mi); em[i] = __expf(-mi);
        t0[i] = (bc[i] - mi) * LOG2E; }
    __syncthreads();
    const int w = F.wave, lane = F.lane, fr = lane & 15, fq = lane >> 4, qi = 16 * w + fr;
    if (F.tid >= 128 && F.tid < 192) nv[F.tid - 128] = nvraw;
#pragma unroll
    for (int i = 0; i < 2; ++i) { const int pc = F.tid + 512 * i, r = pc >> 3;
        *(LAS u32x4*)(Kimg + r * RS64 + kch * 16) = conv8_finish(kr[i], kw8, row0 + r, 0.125f); }
#pragma unroll
    for (int i = 0; i < 4; ++i) { const int pc = F.tid + 512 * i, r = pc >> 4, ch = pc & 15; *(LAS u32x4*)(Vimg + r * RS128 + ch * 16) = vraw[i]; }
#pragma unroll
    for (int i = 0; i < 2; ++i) { const int pc = F.tid + 512 * i, r = pc >> 3, ch = pc & 7; *(LAS u32x4*)(Cimg + r * RS64 + ch * 16) = craw[i]; }
    Conv8Rows qr[2]; Conv8W qw8[2];
#pragma unroll
    for (int ks = 0; ks < 2; ++ks) { qr[ks] = conv8_rows(Z, row0 + qi, ZC_MQ + h * 64 + 32 * ks + 8 * fq); qw8[ks] = conv8_weights(P.conv_w + h * 64 + 32 * ks + 8 * fq); }
    bf16x8 qf[2];
#pragma unroll
    for (int ks = 0; ks < 2; ++ks) qf[ks] = as_bf16x8(conv8_finish(qr[ks], qw8[ks], row0 + qi, 1.0f));
    __syncthreads();
    const LAS float* rlog = t0;
    float qn = 0.f;
#pragma unroll
    for (int ks = 0; ks < 2; ++ks)
#pragma unroll
        for (int e = 0; e < 8; ++e) qn += bf2f((bf16_t)qf[ks][e]) * nv[32 * ks + 8 * fq + e];
    qn += __shfl_xor(qn, 16); qn += __shfl_xor(qn, 32);
    f32x4 intra[8];
#pragma unroll
    for (int dvt = 0; dvt < 8; ++dvt) intra[dvt] = (f32x4){0.f, 0.f, 0.f, 0.f};
    const float rl = rlog[qi];
    float rsum = 0.f;
    for (int kp = 0; kp <= (w >> 1); ++kp) {
        u32x2 pp[2];
#pragma unroll
        for (int t = 0; t < 2; ++t) {
            const int kt = 2 * kp + t;
            f32x4 s = {0.f, 0.f, 0.f, 0.f};
            if (kt <= w) {
#pragma unroll
                for (int ks = 0; ks < 2; ++ks) s = mfma16(rowfrag(Kimg, RS64, 16 * kt + fr, (32 * ks + 8 * fq) * 2), qf[ks], s);
            }
            float p[4];
#pragma unroll
            for (int e = 0; e < 4; ++e) { const int kj = 16 * kt + 4 * fq + e; p[e] = (kj <= qi) ? s[e] * fast_exp2(rl + clog[kj & 127]) : 0.f; rsum += p[e]; }
            pp[t].x = cvt_pk_bf16(p[0], p[1]); pp[t].y = cvt_pk_bf16(p[2], p[3]);
        }
        const bf16x8 pb = as_bf16x8((u32x4){pp[0].x, pp[0].y, pp[1].x, pp[1].y});
#pragma unroll
        for (int dvt = 0; dvt < 8; ++dvt) intra[dvt] = mfma16(TR_PERM(Vimg, RS128, 32 * kp, 16 * dvt, lane), pb, intra[dvt]);
    }
    rsum += __shfl_xor(rsum, 16); rsum += __shfl_xor(rsum, 32);
    const bf16_t* gp = Z + (size_t)(row0 + qi) * NZ + ZC_MO + h * 128;
    f32x4 nwv[8]; u32x2 gvv[8];
#pragma unroll
    for (int dvt = 0; dvt < 8; ++dvt) { nwv[dvt] = *(const f32x4*)(P.ml_norm_w + h * 128 + 16 * dvt + 4 * fq); gvv[dvt] = *(const u32x2*)(gp + 16 * dvt + 4 * fq); }
    const float wq = wi[qi], den = rsum + wq * qn, dinv = 1.0f / fmaxf(fabsf(den), em[qi]);
    float ss = 0.f;
#pragma unroll
    for (int dvt = 0; dvt < 8; ++dvt) { f32x4 a = {0.f, 0.f, 0.f, 0.f};
#pragma unroll
        for (int ks = 0; ks < 2; ++ks) a = mfma16(rowfrag(Cimg, RS64, 16 * dvt + fr, (32 * ks + 8 * fq) * 2), qf[ks], a);
        intra[dvt] = (intra[dvt] + a * wq) * dinv; const f32x4 x = intra[dvt]; ss += (x[0] * x[0] + x[1] * x[1]) + (x[2] * x[2] + x[3] * x[3]); }
    ss += __shfl_xor(ss, 16); ss += __shfl_xor(ss, 32);
    const float hr = __builtin_amdgcn_rsqf(ss * (1.0f / 128.0f) + EPS);
    bf16_t* O = (bf16_t*)(F.ws + WS_O) + (size_t)(row0 + qi) * OW + OC_ML + h * 128;
#pragma unroll
    for (int dvt = 0; dvt < 8; ++dvt) { const int dv = 16 * dvt + 4 * fq;
        const f32x4 nw = nwv[dvt]; const u32x2 gv = gvv[dvt];
        const f32x4 x = intra[dvt] * hr * nw;
        u32x2 o; o.x = cvt_pk_bf16(x[0] * sigmoidf_(bf_lo(gv.x)), x[1] * sigmoidf_(bf_hi(gv.x))); o.y = cvt_pk_bf16(x[2] * sigmoidf_(bf_lo(gv.y)), x[3] * sigmoidf_(bf_hi(gv.y)));
        *(u32x2*)(O + dv) = o; }
    __syncthreads();
}
struct MoeP { const float *w_router, *b_router, *w_gate, *w_up, *w_down, *norm2_w; };
__device__ __forceinline__ void moe_R1(const Frame& F, const MoeP& M, const bf16_t* xres, const float* ssqp) {
    LAS float* WrT = (LAS float*)F.lds;
    LAS int* pickE = (LAS int*)(F.lds + 32768);
    LAS int* lrank = pickE + 256;
    for (int i = F.tid; i < 8 * D; i += 512) { const int e = i >> 10, k = i & 1023; WrT[i] = M.norm2_w[k] * M.w_router[k * 8 + e]; }
    __syncthreads();
    unsigned* toke = (unsigned*)(F.ws + WS_TOKE); float* tokp = (float*)(F.ws + WS_TOKP); float* tokr = (float*)(F.ws + WS_TOKR);
    int* toks = (int*)(F.ws + WS_TOKS); int* elist = (int*)(F.ws + WS_ELIST); unsigned* cnt = (unsigned*)(F.ws + WS_CTL) + CW_CNT;
    const int lane = F.lane;
    for (int tb = blockIdx.x; tb < T / 128; tb += F.G) {
        u32x2 rn[4]; f32x4 sn[4];
        { const int t0 = tb * 128 + F.wave * 16; const u32x2* xr = (const u32x2*)(xres + (size_t)t0 * (2 * D)) + lane; const f32x4* sp = (const f32x4*)(ssqp + (size_t)t0 * 16);
#pragma unroll
            for (int j = 0; j < 4; ++j) { rn[j] = xr[64 * j]; sn[j] = sp[j]; } }
        for (int it = 0; it < 16; ++it) {
            const int tl = F.wave * 16 + it, t = tb * 128 + tl;
            f32x4 v[4];
#pragma unroll
            for (int j = 0; j < 4; ++j) { const u32x2 r = rn[j]; v[j] = (f32x4){bf_lo(r.x), bf_hi(r.x), bf_lo(r.y), bf_hi(r.y)}; }
            const f32x4 ssum = (sn[0] + sn[1]) + (sn[2] + sn[3]);
            const float rstd = __builtin_amdgcn_rsqf(((ssum[0] + ssum[1]) + (ssum[2] + ssum[3])) * (1.0f / D) + EPS);
            if (it < 15) { const u32x2* xr = (const u32x2*)(xres + (size_t)(t + 1) * (2 * D)) + lane; const f32x4* sp = (const f32x4*)(ssqp + (size_t)(t + 1) * 16);
#pragma unroll
                for (int j = 0; j < 4; ++j) { rn[j] = xr[64 * j]; sn[j] = sp[j]; } }
            float lg[8];
#pragma unroll
            for (int e = 0; e < 8; ++e) { float a = 0.f;
#pragma unroll
                for (int j = 0; j < 4; ++j) { const f32x4 wv = *(const LAS f32x4*)(WrT + e * D + 256 * j + 4 * lane); a += (v[j][0] * wv[0] + v[j][1] * wv[1]) + (v[j][2] * wv[2] + v[j][3] * wv[3]); }
                lg[e] = wave_sum(a) * rstd + M.b_router[e]; }
            int e1 = 0; float v1 = lg[0];
#pragma unroll
            for (int e = 1; e < 8; ++e) if (lg[e] > v1) { v1 = lg[e]; e1 = e; }
            int e2 = -1; float v2 = -3.0e38f;
#pragma unroll
            for (int e = 0; e < 8; ++e) if (e != e1 && lg[e] > v2) { v2 = lg[e]; e2 = e; }
            if (lane == 0) { toke[t] = (unsigned)e1 | ((unsigned)e2 << 8); tokp[t] = 1.0f / (1.0f + __expf(v2 - v1)); tokr[t] = rstd; pickE[tl * 2] = e1; pickE[tl * 2 + 1] = e2; }
        }
        __syncthreads();
        if (F.wave == 0) {
            int pe[4], lr[4], mine = 0;
#pragma unroll
            for (int r = 0; r < 4; ++r) { pe[r] = pickE[r * 64 + lane]; lr[r] = 0; }
#pragma unroll
            for (int e = 0; e < 8; ++e) {
                int base = 0;
#pragma unroll
                for (int r = 0; r < 4; ++r) { const bool m = pe[r] == e; const unsigned long long bal = __ballot(m);
                    if (m) lr[r] = base + __popcll(bal & ((1ull << lane) - 1ull)); base += __popcll(bal); }
                if (lane == e) mine = base;
            }
            int gbv = 0; if (lane < 8 && mine > 0) gbv = (int)atomicAdd(cnt + 64 * lane, (unsigned)mine);
#pragma unroll
            for (int r = 0; r < 4; ++r) { const int ent = r * 64 + lane, e = pe[r]; const int rank = __shfl(gbv, e) + lr[r]; toks[(size_t)tb * 256 + ent] = rank; elist[(size_t)e * T + rank] = tb * 128 + (ent >> 1); }
        }
        __syncthreads();
    }
}
__device__ __forceinline__ void moe_R2(const Frame& F, const bf16_t* xres) {
    LAS int* ts = (LAS int*)F.lds; LAS int* cn = ts + 16;
    const unsigned* cnt = (const unsigned*)(F.ws + WS_CTL) + CW_CNT;
    if (F.tid < 8) cn[F.tid] = (int)__hip_atomic_load(cnt + 64 * F.tid, __ATOMIC_RELAXED, __HIP_MEMORY_SCOPE_AGENT);
    __syncthreads();
    if (F.tid == 0) { int acc = 0; for (int e = 0; e < 8; ++e) { const int c = cn[e]; ts[e] = acc; acc += (c + 255) >> 8; } ts[8] = acc;
        if (blockIdx.x == 0) { int* g = (int*)(F.ws + WS_TS); for (int e = 0; e < 9; ++e) g[e] = ts[e]; } }
    __syncthreads();
    const int nslot = ts[8] * 256, lane = F.lane;
    const bf16_t* xb = xres; unsigned char* xg = F.ws + WS_XG;
    const int* elist = (const int*)(F.ws + WS_ELIST); const float* tokr = (const float*)(F.ws + WS_TOKR);
    for (int slot0 = F.gw; slot0 < nslot; slot0 += 4 * F.NGW) {
        int tk[4]; bool ok[4];
#pragma unroll
        for (int q = 0; q < 4; ++q) { const int slot = slot0 + q * F.NGW; ok[q] = false; tk[q] = 0;
            if (slot < nslot) { const int mt = slot >> 8; int e = 0;
#pragma unroll
                for (int k = 1; k < 8; ++k) e += (mt >= ts[k]);
                const int r = slot - ts[e] * 256;
                if (r < cn[e]) { ok[q] = true; tk[q] = elist[(size_t)e * T + r]; } } }
        u32x4 a[4], b[4]; float rs[4];
#pragma unroll
        for (int q = 0; q < 4; ++q) { a[q] = (u32x4){0u, 0u, 0u, 0u}; b[q] = a[q]; rs[q] = 0.f;
            if (ok[q]) { const u32x4* src = (const u32x4*)(xb + (size_t)tk[q] * (2 * D)); a[q] = __builtin_nontemporal_load(src + 2 * lane); b[q] = __builtin_nontemporal_load(src + 2 * lane + 1); rs[q] = tokr[tk[q]]; } }
#pragma unroll
        for (int q = 0; q < 4; ++q) { const int slot = slot0 + q * F.NGW;
            if (slot < nslot) {
                u32x4 w8; const float sc = ACT8_SCALE * rs[q];
                w8.x = cvt_pk4_fp8(bf_lo(a[q].x) * sc, bf_hi(a[q].x) * sc, bf_lo(a[q].y) * sc, bf_hi(a[q].y) * sc);
                w8.y = cvt_pk4_fp8(bf_lo(a[q].z) * sc, bf_hi(a[q].z) * sc, bf_lo(a[q].w) * sc, bf_hi(a[q].w) * sc);
                w8.z = cvt_pk4_fp8(bf_lo(b[q].x) * sc, bf_hi(b[q].x) * sc, bf_lo(b[q].y) * sc, bf_hi(b[q].y) * sc);
                w8.w = cvt_pk4_fp8(bf_lo(b[q].z) * sc, bf_hi(b[q].z) * sc, bf_lo(b[q].w) * sc, bf_hi(b[q].w) * sc);
                ((u32x4*)(xg + (size_t)slot * D))[lane] = w8; } }
    }
}
__device__ __forceinline__ void moe_combine(const Frame& F, float* out, const bf16_t* xres) {
    const unsigned* toke = (const unsigned*)(F.ws + WS_TOKE); const float* tokp = (const float*)(F.ws + WS_TOKP); const int* toks = (const int*)(F.ws + WS_TOKS);
    const int* ts = (const int*)(F.ws + WS_TS); const bf16_t* yd = (const bf16_t*)(F.ws + WS_YD);
    for (int t0 = F.gw; t0 < T; t0 += 2 * F.NGW) {
        unsigned ee[2]; float p1[2]; int r1[2], r2[2];
#pragma unroll
        for (int q = 0; q < 2; ++q) { const int t = (t0 + q * F.NGW < T) ? t0 + q * F.NGW : t0; ee[q] = toke[t]; p1[q] = tokp[t]; r1[q] = toks[2 * (size_t)t]; r2[q] = toks[2 * (size_t)t + 1]; }
        size_t s1[2], s2[2];
#pragma unroll
        for (int q = 0; q < 2; ++q) { const int e1 = ee[q] & 255, e2 = (ee[q] >> 8) & 255; s1[q] = (size_t)ts[e1] * 256 + r1[q]; s2[q] = (size_t)ts[e2] * 256 + r2[q]; }
        u32x2 x[2][4]; u32x2 ya[2][4], yb[2][4];
#pragma unroll
        for (int q = 0; q < 2; ++q) { const int t = (t0 + q * F.NGW < T) ? t0 + q * F.NGW : t0;
            const u32x2* o = (const u32x2*)(xres + (size_t)t * (2 * D)) + F.lane; const u32x2* y1 = (const u32x2*)(yd + s1[q] * D) + F.lane; const u32x2* y2 = (const u32x2*)(yd + s2[q] * D) + F.lane;
#pragma unroll
            for (int j = 0; j < 4; ++j) { x[q][j] = __builtin_nontemporal_load(o + 64 * j); ya[q][j] = __builtin_nontemporal_load(y1 + 64 * j); yb[q][j] = __builtin_nontemporal_load(y2 + 64 * j); } }
#pragma unroll
        for (int q = 0; q < 2; ++q) { const int t = t0 + q * F.NGW; const float pa = p1[q], pb = 1.0f - pa;
            if (t >= T) break;
            f32x4* o = (f32x4*)(out + (size_t)t * D) + F.lane;
#pragma unroll
            for (int j = 0; j < 4; ++j) { const u32x2 xr = x[q][j]; f32x4 v = {bf_lo(xr.x), bf_hi(xr.x), bf_lo(xr.y), bf_hi(xr.y)}; const u32x2 a = ya[q][j], b = yb[q][j];
                v[0] += pa * bf_lo(a.x) + pb * bf_lo(b.x); v[1] += pa * bf_hi(a.x) + pb * bf_hi(b.x); v[2] += pa * bf_lo(a.y) + pb * bf_lo(b.y); v[3] += pa * bf_hi(a.y) + pb * bf_hi(b.y);
                o[64 * j] = v; } }
    }
}

#define CAS __attribute__((address_space(4)))
struct Args { const float* in[23]; float* out; unsigned char* ws; int ph_lo, ph_hi, li, pad; };
template <class T> __device__ __forceinline__ T* asg(T* p) { return (T*)(GAS T*)p; }
__device__ __forceinline__ const CAS Args* kargs() { unsigned zo = 0u; asm volatile("" : "+s"(zo)); return (const CAS Args*)((const CAS char*)__builtin_amdgcn_kernarg_segment_ptr() + zo); }
__device__ __forceinline__ int wg_index() { int c = (int)blockIdx.x; asm volatile("" : "+s"(c)); return c; }
__device__ __forceinline__ bool refresh(Frame& F) { F.ws = asg(kargs()->ws); int t = threadIdx.x; asm volatile("" : "+v"(t)); F.tid = t; F.lane = t & 63; F.wave = __builtin_amdgcn_readfirstlane(t >> 6); F.gw = blockIdx.x * 8 + F.wave; return true; }
#ifndef EN_MASK
#define EN_MASK 0xFFFF
#endif
#define EN(k) ((EN_MASK >> (k)) & 1)
#ifndef REP_G1
#define REP_G1 1
#endif
#ifndef REP_MIX
#define REP_MIX 1
#endif
#ifndef REP_A
#define REP_A REP_MIX
#endif
#ifndef REP_B
#define REP_B REP_MIX
#endif
#ifndef REP_C
#define REP_C REP_MIX
#endif
#ifndef REP_FFNUP
#define REP_FFNUP 1
#endif
#ifndef REP_MUP
#define REP_MUP 1
#endif
#ifndef REP_G2
#define REP_G2 1
#endif
#ifndef REP_CONV
#define REP_CONV 1
#endif
#ifndef REP_MOE
#define REP_MOE 1
#endif
#define RUN() (lo <= ph && ph < hi && refresh(F))
#define SEAM() do { if (lo <= ph && ph + 1 < hi) { const CAS Args* ka_ = kargs(); XcdBarrier bar_; bar_.bar = (unsigned*)(asg(ka_->ws) + WS_CTL) + CW_BAR + ka_->li * XCD_BAR_WORDS; bar_.x = xb_xcc_id(); bar_.st = (volatile LAS unsigned*)(F.lds + MISC_OFF) + 8; xcd_barrier(bar_); } ++ph; } while (0)
#define SEAM_X() do { if (lo <= ph && ph + 1 < hi) { volatile LAS unsigned* st_ = (volatile LAS unsigned*)(F.lds + MISC_OFF) + 8; const CAS Args* ka_ = kargs(); unsigned* bw_ = (unsigned*)(asg(ka_->ws) + WS_CTL) + CW_BAR + ka_->li * XCD_BAR_WORDS; \
        if (st_[2]) xcd_local_barrier(bw_, xb_xcc_id(), st_[0]); else { XcdBarrier bar_; bar_.bar = bw_; bar_.x = xb_xcc_id(); bar_.st = st_; xcd_barrier(bar_); } } ++ph; } while (0)
#define x_in (asg(kargs()->in[0]))
#define out (asg(kargs()->out))
#define ssq ((float*)(F.ws + WS_SSQ))
#define XB ((bf16_t*)(F.ws + WS_XB))
#define lo (kargs()->ph_lo)
#define hi (kargs()->ph_hi)
#define MKP() LayerP P; P.ret_norm_w = asg(kargs()->in[3]) + layer * 512; P.da_qw = asg(kargs()->in[4]) + layer * 64; P.da_kw = asg(kargs()->in[5]) + layer * 64; P.conv_w = asg(kargs()->in[6]) + layer * 2048; \
        P.i_bias = asg(kargs()->in[7]) + layer * 4; P.f_bias = asg(kargs()->in[8]) + layer * 4; P.ml_norm_w = asg(kargs()->in[9]) + layer * 512
__device__ __forceinline__ void group_phases(Frame& F, int& ph, const int layer, const int g) {
    const volatile LAS unsigned* stx = (const volatile LAS unsigned*)(F.lds + MISC_OFF) + 8;
    const int c = __builtin_amdgcn_readfirstlane(stx[2] ? (int)(stx[4] * 8u + xb_xcc_id()) : (int)blockIdx.x);
            if (EN(1) && RUN()) {
                LAS float* rtab = (LAS float*)(F.lds + MISC_OFF + 1024);
                {
                    pg8::Gemm gm{XB + (size_t)g * TG * D, (const bf16_t*)(F.ws + WS_WIN) + (size_t)layer * NZ * D, D * 2, D * 2, D / 64, 0};
                    pg8::ListOrder S; S.init(TG, 16 * 256, F.G, c); S.tl_lo = TL16_LO; S.tl_hi = TL16_HI;
                    pg8::EpiG1 E{(bf16_t*)(F.ws + WS_Z), (float*)(F.ws + WS_GATES), rtab, (const float*)(F.ws + WS_ROPE), asg(kargs()->in[4]) + layer * 64, asg(kargs()->in[5]) + layer * 64, 1};
                    pg8::fill_rstd_table(S, ssq + (size_t)g * TG * 16, rtab, 2);
                    for (int rep = 0; rep < REP_G1; ++rep) pg8::gemm_phase<pg8::EpiG1, pg8::ListOrder, true, true>(F.lds, gm, S, E);
                }
                {
                    pg8::Gemm gm{F.ws + WS_XB8G, F.ws + WS_WIN + (size_t)layer * NZ * D * 2, D, 2 * D, D / 128, 0};
                    pg8::ListOrder S; S.init(TG, 20 * 256, F.G, c); S.tl_lo = TL20_LO; S.tl_hi = TL20_HI;
                    pg8::EpiGate8 E{(bf16_t*)(F.ws + WS_Z), rtab + 8 * 256, 1};
                    pg8::fill_rstd_table(S, ssq + (size_t)g * TG * 16, rtab + 8 * 256, 2);
                    for (int rep = 0; rep < REP_G1; ++rep) pg8::gemm_phase<pg8::EpiGate8, pg8::ListOrder, true, false, true>(F.lds, gm, S, E);
                }
            }
            SEAM_X();
            if (EN(2) && RUN()) {
                MKP();
                for (int rep = 0; rep < REP_A; ++rep) for (int u = c; u < 1792; u += F.G) { const int bl = u & 7, v = u >> 3;
                    if (v < 64) ret_A(F, bl * 64 + v); else if (v < 128) ml_A(F, P, bl * 64 + v - 64); else vt_A(F, bl * 96 + v - 128); }
            }
            SEAM_X();
            if (EN(3) && RUN()) {
                MKP();
                scan_B(F, c);
                for (int rep = 0; rep < REP_B; ++rep) for (int u = c; u < 256; u += F.G) attn_B(F, P, (u & 7) * 32 + (u >> 3));
            }
            SEAM_X();
            if (EN(4) && RUN()) {
                MKP();
                for (int rep = 0; rep < REP_C; ++rep) for (int u = c; u < 1024; u += F.G) { const int bl = u & 7, v = u >> 3; if (v < 64) ret_C(F, P, bl * 64 + v); else ml_C(F, P, bl * 64 + v - 64); }
            }
            SEAM_X();
            if (EN(5) && RUN()) {
                for (int jr = 0; jr < 3 * REP_G2; ++jr) { const int j = jr % 3;
                    const int kofs = j == 0 ? 0 : (j == 1 ? 512 : 768), kk = j == 1 ? 256 : 512;
                    pg8::Gemm gm{(const bf16_t*)(F.ws + WS_O) + kofs, (const bf16_t*)(F.ws + WS_WBR) + (size_t)layer * D * OW + kofs, OW * 2, OW * 2, kk / 64, 0};
                    pg8::StaticOrder S; S.init(TG, D, F.G, c);
                    pg8::EpiBranch E{(bf16_t*)(F.ws + WS_Y), (const bf16_t*)(F.ws + WS_Z) + ZC_SG + 1024 * j, j == 0};
                    pg8::gemm_phase<pg8::EpiBranch, pg8::StaticOrder, true, true>(F.lds, gm, S, E);
                }
            }
            SEAM_X();
            if (EN(6) && RUN()) {
                pg8::Gemm gm{(const bf16_t*)(F.ws + WS_Y), (const bf16_t*)(F.ws + WS_WOUT) + (size_t)layer * D * D, D * 2, D * 2, D / 64, 0};
                pg8::StaticOrder S; S.init(TG, D, F.G, c);
                const size_t ro = (size_t)g * TG * D;
                unsigned char* xb8 = nullptr;
                if (g == 0) {
                    const u32x4* src = (const u32x4*)(XB + (size_t)TG * D); u32x2* dst = (u32x2*)(F.ws + WS_XB8G);
                    const size_t per_b = (size_t)SEQ * D / 8;
                    for (size_t j = (size_t)(c >> 3) * 512 + F.tid; j < per_b; j += (size_t)(F.G >> 3) * 512) { const size_t i = (size_t)(c & 7) * per_b + j; const u32x4 v = src[i]; u32x2 w8;
                        w8.x = cvt_pk4_fp8(bf_lo(v.x) * ACT8_SCALE, bf_hi(v.x) * ACT8_SCALE, bf_lo(v.y) * ACT8_SCALE, bf_hi(v.y) * ACT8_SCALE);
                        w8.y = cvt_pk4_fp8(bf_lo(v.z) * ACT8_SCALE, bf_hi(v.z) * ACT8_SCALE, bf_lo(v.w) * ACT8_SCALE, bf_hi(v.w) * ACT8_SCALE); dst[i] = w8; }
                }
                pg8::EpiResid E{XB + ro, nullptr, layer == 0 ? XB + ro : (bf16_t*)out + 2 * ro, ssq + (size_t)g * TG * 16, xb8, layer == 0 ? D : 2 * D};
                pg8::gemm_phase<pg8::EpiResid, pg8::StaticOrder, true, true>(F.lds, gm, S, E);
            }
            if (g + 1 < NGRP) SEAM_X(); else SEAM();
}
__global__ void __launch_bounds__(512, 2) fwd(Args args) {
    extern __shared__ __attribute__((aligned(16))) unsigned char lds_raw[];
    Frame F;
    F.lds = (LAS unsigned char*)lds_raw; F.ws = asg(kargs()->ws);
    F.tid = threadIdx.x; F.lane = F.tid & 63; F.wave = __builtin_amdgcn_readfirstlane(F.tid >> 6);
    F.G = gridDim.x; F.gw = blockIdx.x * 8 + F.wave; F.NGW = F.G * 8;
    volatile LAS unsigned* MISC = (volatile LAS unsigned*)(F.lds + MISC_OFF);
    if (F.tid < 64) MISC[F.tid] = 0u;
    __syncthreads();
    (void)xcd_barrier_post((unsigned*)(F.ws + WS_CTL) + CW_BAR + kargs()->li * XCD_BAR_WORDS, MISC + 8);
    int ph = 0;

    if (EN(0) && RUN()) {
        int woff = 0;
        for (int l = 0; l < 2 * REP_CONV; ++l) {
            convert_w<false>(F, woff, PIN, D, 16 * 256, (bf16_t*)(F.ws + WS_WIN) + (size_t)(l & 1) * NZ * D, D, 0, asg(kargs()->in[1]) + (l & 1) * D, MapWinSel{asg(kargs()->in[2]) + (size_t)(l & 1) * D * PIN, TL16_LO, TL16_HI});
            convert_w<true>(F, woff, PIN, D, 20 * 256, F.ws + WS_WIN + (size_t)(l & 1) * NZ * D * 2, 2 * D, 0, asg(kargs()->in[1]) + (l & 1) * D, MapWinSel{asg(kargs()->in[2]) + (size_t)(l & 1) * D * PIN, TL20_LO, TL20_HI});
            convert_w<false>(F, woff, D, 512, D, (bf16_t*)(F.ws + WS_WBR) + (size_t)(l & 1) * D * OW, OW, 0, nullptr, MapIdent{asg(kargs()->in[10]) + (size_t)(l & 1) * 512 * D});
            convert_w<false>(F, woff, D, 256, D, (bf16_t*)(F.ws + WS_WBR) + (size_t)(l & 1) * D * OW, OW, 512, nullptr, MapIdent{asg(kargs()->in[11]) + (size_t)(l & 1) * 256 * D});
            convert_w<false>(F, woff, D, 512, D, (bf16_t*)(F.ws + WS_WBR) + (size_t)(l & 1) * D * OW, OW, 768, nullptr, MapIdent{asg(kargs()->in[12]) + (size_t)(l & 1) * 512 * D});
            convert_w<false>(F, woff, D, D, D, (bf16_t*)(F.ws + WS_WOUT) + (size_t)(l & 1) * D * D, D, 0, nullptr, MapIdent{asg(kargs()->in[13]) + (size_t)(l & 1) * D * D});
        }
        convert_w<false>(F, woff, FF, D, 2 * FF, F.ws + WS_WUP, D, 0, asg(kargs()->in[14]), MapGateUp{asg(kargs()->in[15]), asg(kargs()->in[16])});
        convert_w<false>(F, woff, D, FF, D, F.ws + WS_WDN, FF, 0, nullptr, MapIdent{asg(kargs()->in[17])});
        p0_rows(F, x_in);
        p0_rope(F);
    }
    SEAM();

    for (int layer = 0; layer < 2; ++layer) {
        for (int g = 0; g < NGRP; ++g) group_phases(F, ph, layer, g);
        if (layer == 0) {
            if (EN(7) && RUN()) {
                pg8::Gemm gm{XB, F.ws + WS_WUP, D * 2, D * 2, D / 64, 0};
                pg8::StaticOrder S; S.init(T, 2 * FF, F.G, wg_index());
                LAS float* rtab = (LAS float*)(F.lds + MISC_OFF + 1024);
                pg8::EpiSwiglu<false> E{F.ws + WS_A1, FF, nullptr, rtab};
                pg8::fill_rstd_table(S, ssq, rtab, 12);
                for (int rep = 0; rep < REP_FFNUP; ++rep) pg8::gemm_phase<pg8::EpiSwiglu<false>, pg8::StaticOrder, true, true, false>(F.lds, gm, S, E);
            }
            SEAM();
            if (EN(8) && RUN()) {
                pg8::Gemm gm{F.ws + WS_A1, F.ws + WS_WDN, FF * 2, FF * 2, FF / 64, 0};
                pg8::StaticOrder S; S.init(T, D, F.G, wg_index());
                pg8::EpiResid E{XB, nullptr, XB, ssq, F.ws + WS_XB8G};
                pg8::gemm_phase<pg8::EpiResid, pg8::StaticOrder, true, true, false>(F.lds, gm, S, E);
            }
            SEAM();
        } else {
            MoeP M{asg(kargs()->in[18]), asg(kargs()->in[19]), asg(kargs()->in[20]), asg(kargs()->in[21]), asg(kargs()->in[22]), asg(kargs()->in[14]) + D};
            if (EN(9) && RUN()) {
                __syncthreads();
                moe_R1(F, M, (const bf16_t*)out, ssq);
            }
            SEAM();
            if (EN(10) && RUN()) {
                int woff = 0;
                for (int er = 0; er < NE * REP_CONV; ++er) { const int e = er % NE;
                    unsigned char* wd = F.ws + WS_WMOE + (size_t)e * WMOE_E_BYTES;
                    convert_w<true>(F, woff, FFE, D, 2 * FFE, wd, D, 0, M.norm2_w, MapGateUp{M.w_gate + (size_t)e * D * FFE, M.w_up + (size_t)e * D * FFE});
                    convert_w<true>(F, woff, D, FFE, D, wd + WMOE_UP_BYTES, FFE, 0, nullptr, MapIdent{M.w_down + (size_t)e * FFE * D});
                }
                moe_R2(F, (const bf16_t*)out);
            }
            SEAM();
            if (EN(11) && RUN()) {
                pg8::Gemm gm{F.ws + WS_XG, F.ws + WS_WMOE, D, D, D / 128, (unsigned)WMOE_E_BYTES};
                pg8::MoeOrder S; S.init_moe((const int*)(F.ws + WS_TS), 2 * FFE, F.G, wg_index());
                pg8::EpiSwiglu<true> E{F.ws + WS_AE, FFE, (const float*)(F.ws + WS_SLOTRS), nullptr};
                for (int rep = 0; rep < REP_MUP; ++rep) pg8::gemm_phase<pg8::EpiSwiglu<true>, pg8::MoeOrder, true, false, true>(F.lds, gm, S, E);
            }
            SEAM();
            if (EN(12) && RUN()) {
                pg8::Gemm gm{F.ws + WS_AE, F.ws + WS_WMOE + WMOE_UP_BYTES, FFE, FFE, FFE / 128, (unsigned)WMOE_E_BYTES};
                pg8::MoeOrder S; S.init_moe((const int*)(F.ws + WS_TS), D, F.G, wg_index());
                pg8::EpiMoeDown E{(bf16_t*)(F.ws + WS_YD), 1};
                pg8::gemm_phase<pg8::EpiMoeDown, pg8::MoeOrder, true, false, true>(F.lds, gm, S, E);
            }
            SEAM();
            if (EN(13) && RUN()) moe_combine(F, out, (const bf16_t*)out);
            SEAM();
        }
    }
#undef RUN
#undef SEAM
#undef x_in
#undef lo
#undef hi
#undef out
#undef ssq
#undef XB
}

#ifndef MK_PER_PHASE
#define MK_PER_PHASE 0
#endif
extern "C" void kernel_launch(void* const* d_in, const int* in_sizes, int n_in, void* d_out, int out_size, void* d_ws, size_t ws_size, hipStream_t stream) {
    static int grid = 0;
    if (grid == 0) {
        if (n_in != 23 || out_size != T * D || ws_size < WS_NEED) { fprintf(stderr, "kernel_launch: unexpected problem shape / workspace (%d inputs, out %d, ws %zu < %zu)\n", n_in, out_size, ws_size, (size_t)WS_NEED); grid = -1; return; }
        int dev = 0, cus = 0, per_cu = 0;
        if (hipGetDevice(&dev) != hipSuccess || hipDeviceGetAttribute(&cus, hipDeviceAttributeMultiprocessorCount, dev) != hipSuccess) { grid = -1; return; }
        if (hipFuncSetAttribute((const void*)fwd, hipFuncAttributeMaxDynamicSharedMemorySize, LDS_BYTES) != hipSuccess) { grid = -1; return; }
        if (hipOccupancyMaxActiveBlocksPerMultiprocessor(&per_cu, (const void*)fwd, 512, LDS_BYTES) != hipSuccess || per_cu < 1) { fprintf(stderr, "kernel_launch: occupancy query reports %d\n", per_cu); }
        (void)hipGetLastError();
        grid = cus;
    }
    if (grid < 0) return;
    if (hipMemsetAsync((char*)d_ws + WS_CTL, 0, CTL_ZERO_BYTES, stream) != hipSuccess) return;
    Args a{};
    for (int i = 0; i < 23; ++i) a.in[i] = (const float*)d_in[i];
    a.out = (float*)d_out; a.ws = (unsigned char*)d_ws;
#if MK_PER_PHASE
    for (int p = 0; p < NPHASES; ++p) { a.ph_lo = p; a.ph_hi = p + 1; a.li = p; hipLaunchKernelGGL(fwd, dim3(grid), dim3(512), LDS_BYTES, stream, a); }
#else
    a.ph_lo = 0; a.ph_hi = 1 << 20; a.li = 0;
    hipLaunchKernelGGL(fwd, dim3(grid), dim3(512), LDS_BYTES, stream, a);
#endif
}
```

```cpp
#include <hip/hip_runtime.h>
#include <stdio.h>
#include <stdint.h>

#define LAS __attribute__((address_space(3)))
#define GAS __attribute__((address_space(1)))
typedef unsigned short bf16_t;
typedef short bf16x8 __attribute__((ext_vector_type(8)));
typedef short s16x4 __attribute__((ext_vector_type(4)));
typedef float f32x4 __attribute__((ext_vector_type(4)));
typedef float f32x2 __attribute__((ext_vector_type(2)));
typedef unsigned u32x4 __attribute__((ext_vector_type(4)));
typedef unsigned u32x2 __attribute__((ext_vector_type(2)));
typedef int i32x8 __attribute__((ext_vector_type(8)));
typedef int i32x4 __attribute__((ext_vector_type(4)));

constexpr int BATCH = 16, SEQ = 2048, D = 1024, T = BATCH * SEQ;
constexpr int NGRP = 2, BG = BATCH / NGRP, TG = BG * SEQ;
constexpr int PIN = 8968, NZ = 9216;
constexpr int ZC_RQ = 0, ZC_RK = 512, ZC_RV = 1024, ZC_RG = 1536, ZC_DQ = 2048, ZC_DK = 2816, ZC_DV = 3584;
constexpr int ZC_MQ = 4352, ZC_MK = 4608, ZC_MV = 4864, ZC_MO = 5376, ZC_GATE = 5888, ZC_SG = 6144;
constexpr int OW = 1280, OC_RET = 0, OC_DA = 512, OC_ML = 768;
constexpr int FF = 2816, FFE = 3584, NE = 8, FFC = 896, NCHUNK = 4;
constexpr int MAXSLOT = 2 * T + NE * 256, MAXMT = MAXSLOT / 256;
constexpr float EPS = 1e-6f;
constexpr float LOG2E = 1.4426950408889634f;

typedef __bf16 bf16x2_t __attribute__((ext_vector_type(2)));
typedef float f32x2_t __attribute__((ext_vector_type(2)));
__device__ __forceinline__ unsigned cvt_pk_bf16(float lo, float hi) { const f32x2_t v = {lo, hi}; return __builtin_bit_cast(unsigned, __builtin_convertvector(v, bf16x2_t)); }
__device__ __forceinline__ unsigned cvt_pk4_fp8(float a, float b, float c, float d) { int p = 0; p = __builtin_amdgcn_cvt_pk_fp8_f32(a, b, p, false); p = __builtin_amdgcn_cvt_pk_fp8_f32(c, d, p, true); return (unsigned)p; }
constexpr float ACT8_SCALE = 4.0f, W8_SCALE = 128.0f;
constexpr int ACT8_E8M0 = 0x7D7D7D7D, W8_E8M0 = 0x78787878;
__device__ __forceinline__ float bf_lo(unsigned u) { return __uint_as_float(u << 16); }
__device__ __forceinline__ float bf_hi(unsigned u) { return __uint_as_float(u & 0xffff0000u); }
__device__ __forceinline__ float bf2f(bf16_t b) { return __uint_as_float(((unsigned)b) << 16); }
__device__ __forceinline__ float fast_exp2(float x) { return __builtin_amdgcn_exp2f(x); }
__device__ __forceinline__ float fast_rcp(float x) { return __builtin_amdgcn_rcpf(x); }
__device__ __forceinline__ float sigmoidf_(float x) { return fast_rcp(1.0f + fast_exp2(-x * LOG2E)); }
__device__ __forceinline__ float siluf_(float x) { return x * sigmoidf_(x); }

namespace pg8 {
constexpr int BM = 256, BK = 64, HALF = 128, HTB = HALF * BK * 2, STAGE_BYTES = 8 * HTB, NXCD = 8, WGM = 8;
__host__ __device__ __forceinline__ int lds_byte(int r, int c) { const int st = (r >> 4) * 2 + (c >> 5), rr = r & 15, cc = c & 31, ob = rr * 64 + cc * 2; return st * 1024 + (ob ^ (((ob >> 9) & 1) << 5)); }
__host__ __device__ __forceinline__ void stage_rc(int b, int& R, int& C) { const int st = b / 1024, sb = b % 1024, swz = sb ^ (((sb >> 9) & 1) << 5); R = (st >> 1) * 16 + swz / 64; C = (st & 1) * 32 + (swz % 64) / 2; }
__host__ __device__ __forceinline__ int perm32(int rho) { const int n = rho >> 4, i = rho & 15; return 8 * (i >> 2) + 4 * n + (i & 3); }

struct Unit { int pm, pn, e; };
struct Gemm { const void* A; const void* Bt; int lda, ldb, nt; unsigned bstride; };

struct StaticOrder {
    int nM, nN, nwg, G, c;
    __device__ void init(int M, int N, int G_, int c_) { nM = M / BM; nN = N / BM; nwg = nM * nN; G = G_; c = c_; }
    __device__ bool next(int i, Unit& u) const {
        const long L = (long)i * G + c; if (L >= nwg) return false;
        int wgid = (int)L; { const int q = nwg / NXCD, r = nwg % NXCD, xcd = wgid % NXCD, off = wgid / NXCD; wgid = (xcd < r ? xcd * (q + 1) : r * (q + 1) + (xcd - r) * q) + off; }
        const int nig = WGM * nN, gid = wgid / nig, fm = gid * WGM, gsz = (nM - fm) < WGM ? (nM - fm) : WGM;
        u.pm = fm + ((wgid % nig) % gsz); u.pn = (wgid % nig) / gsz; u.e = 0; return true;
    }
    __device__ __forceinline__ void a_ready(const Unit&) const {}
    __device__ __forceinline__ void done(const Unit&) const {}
};
struct ListOrder : StaticOrder {
    unsigned long long tl_lo, tl_hi;
    __device__ bool next(int i, Unit& u) const {
        if (!StaticOrder::next(i, u)) return false;
        const int k = u.pn; const unsigned long long w = k < 10 ? tl_lo : tl_hi; u.pn = (int)((w >> (6 * (k < 10 ? k : k - 10))) & 63ull); return true;
    }
};
struct MoeOrder : StaticOrder {
    int t1, t2, t3, t4, t5, t6, t7;
    __device__ void init_moe(const int* ts, int N, int G_, int c_) {
#define RFL(x) __builtin_amdgcn_readfirstlane(x)
        t1 = RFL(ts[1]); t2 = RFL(ts[2]); t3 = RFL(ts[3]); t4 = RFL(ts[4]); t5 = RFL(ts[5]); t6 = RFL(ts[6]); t7 = RFL(ts[7]);
        init(RFL(ts[8]) * BM, N, G_, c_);
#undef RFL
    }
    __device__ bool next(int i, Unit& u) const {
        if (!StaticOrder::next(i, u)) return false;
        const int p = u.pm; u.e = __builtin_amdgcn_readfirstlane((p >= t1) + (p >= t2) + (p >= t3) + (p >= t4) + (p >= t5) + (p >= t6) + (p >= t7)); return true;
    }
};

template <class Epi, class Sched, bool ALIGN_EPI = false, bool SP2 = false, bool FP8 = false>
__device__ __forceinline__ void gemm_phase(LAS unsigned char* lds, const Gemm g, const Sched& S, const Epi& E) {
    int tid_ = threadIdx.x; asm volatile("" : "+v"(tid_));
    const int tid = tid_, wid = __builtin_amdgcn_readfirstlane(tid >> 6), lane = tid & 63, wr = wid >> 2, wc = wid & 3, fr = lane & 15, fq = lane >> 4;
    int nt_ = g.nt; asm volatile("" : "+s"(nt_)); const int nt = nt_;
    unsigned voffA, voffB;
    { int R, C; stage_rc(tid * 16, R, C); const int Rb = Epi::PERM ? ((R & ~31) + perm32(R & 31)) : R;
        voffA = (unsigned)(R * g.lda + C * 2); voffB = (unsigned)(Rb * g.ldb + C * 2); }
    const size_t qstepA = (size_t)64 * g.lda, qstepB = (size_t)64 * g.ldb;
    const size_t kstep = (size_t)(BK * 2);
    const size_t hstepA = (size_t)HALF * g.lda, hstepB = (size_t)HALF * g.ldb;
    const size_t tstepA = 2 * hstepA, tstepB = 2 * hstepB;
    const unsigned ldsw = (unsigned)wid * 1024u;
    const int aoff = lds_byte(wr * 64 + fr, fq * 8), boff = lds_byte(wc * 32 + fr, fq * 8);
#define PG8_SA(b, h) (((b) * 2 + (h)) * HTB)
#define PG8_SB(b, h) ((4 + (b) * 2 + (h)) * HTB)
#define PG8_STAGE(bufoff, gbase, voff) do { _Pragma("unroll") for (int _i = 0; _i < 2; ++_i) { \
        unsigned long long _gb = (unsigned long long)(gbase) + (_i ? q##voff : 0); asm volatile("" : "+s"(_gb));     \
        __builtin_amdgcn_global_load_lds((const GAS unsigned*)((const GAS char*)_gb + (voff)), (LAS unsigned*)(lds + (bufoff) + ldsw + _i * 8192), 16, 0, 0); } } while (0)
#define qvoffA qstepA
#define qvoffB qstepB
#define PG8_LDA(dst, b, h) do { _Pragma("unroll") for (int m = 0; m < 4; ++m) _Pragma("unroll") for (int k = 0; k < 2; ++k) dst[m][k] = *(const LAS bf16x8*)(lds + PG8_SA(b, h) + aoff + m * 2048 + k * 1024); } while (0)
#define PG8_LDB(dst, b, h) do { _Pragma("unroll") for (int n = 0; n < 2; ++n) _Pragma("unroll") for (int k = 0; k < 2; ++k) dst[n][k] = *(const LAS bf16x8*)(lds + PG8_SB(b, h) + boff + n * 2048 + k * 1024); } while (0)
#define PG8_CAT(x) __builtin_shufflevector(__builtin_bit_cast(i32x4, (x)[0]), __builtin_bit_cast(i32x4, (x)[1]), 0, 1, 2, 3, 4, 5, 6, 7)
#define PG8_MMA(ai, bj, At, Bt) do { __builtin_amdgcn_s_setprio(2); _Pragma("unroll") for (int m = 0; m < 4; ++m) _Pragma("unroll") for (int n = 0; n < 2; ++n) { \
        if constexpr (FP8) acc[ai][bj][m][n] = __builtin_amdgcn_mfma_scale_f32_16x16x128_f8f6f4(PG8_CAT(Bt[n]), PG8_CAT(At[m]), acc[ai][bj][m][n], 0, 0, 0, W8_E8M0, 0, ACT8_E8M0); \
        else { _Pragma("unroll") for (int k = 0; k < 2; ++k) acc[ai][bj][m][n] = __builtin_amdgcn_mfma_f32_16x16x32_bf16(Bt[n][k], At[m][k], acc[ai][bj][m][n], 0, 0, 0); } } \
        __builtin_amdgcn_s_setprio(0); } while (0)
#define PG8_WAIT_V(n) asm volatile("s_waitcnt vmcnt(" #n ")" ::: "memory")
#define PG8_WAIT_L(n) asm volatile("s_waitcnt lgkmcnt(" #n ")" ::: "memory")
#define PG8_BAR __builtin_amdgcn_s_barrier()
#define PG8_SCHED __builtin_amdgcn_sched_barrier(0)
    Unit cur, nxt; int ui = 0;
    if (!S.next(0, cur)) return;
    f32x4 acc[2][2][4][2];
#pragma unroll
    for (int a = 0; a < 2; ++a)
#pragma unroll
        for (int b = 0; b < 2; ++b)
#pragma unroll
            for (int m = 0; m < 4; ++m)
#pragma unroll
                for (int n = 0; n < 2; ++n) acc[a][b][m][n] = (f32x4){0.f, 0.f, 0.f, 0.f};
    bf16x8 At[4][2], B0[2][2], B1[2][2];
    const char* cA = (const char*)g.A + (size_t)cur.pm * tstepA; const char* cB = (const char*)g.Bt + (size_t)((unsigned)cur.e * g.bstride) + (size_t)cur.pn * tstepB;
    S.a_ready(cur);
    if constexpr (SP2) {
        PG8_STAGE(PG8_SB(0, 0), cB, voffB); PG8_STAGE(PG8_SB(0, 1), cB + hstepB, voffB); PG8_STAGE(PG8_SA(0, 0), cA, voffA); PG8_STAGE(PG8_SA(0, 1), cA + hstepA, voffA);
        if (wr == 1) PG8_BAR;
        PG8_WAIT_V(2); PG8_BAR;
        PG8_STAGE(PG8_SB(1, 0), cB + kstep, voffB); PG8_STAGE(PG8_SA(1, 0), cA + kstep, voffA); PG8_STAGE(PG8_SB(1, 1), cB + hstepB + kstep, voffB);
        PG8_WAIT_V(6); PG8_BAR;
    } else {
        PG8_STAGE(PG8_SB(0, 0), cB, voffB); PG8_STAGE(PG8_SA(0, 0), cA, voffA); PG8_STAGE(PG8_SB(0, 1), cB + hstepB, voffB); PG8_STAGE(PG8_SA(0, 1), cA + hstepA, voffA);
        if (wr == 1) PG8_BAR;
        PG8_WAIT_V(4); PG8_BAR;
        PG8_STAGE(PG8_SB(1, 0), cB + kstep, voffB); PG8_STAGE(PG8_SA(1, 0), cA + kstep, voffA); PG8_STAGE(PG8_SB(1, 1), cB + hstepB + kstep, voffB);
        PG8_WAIT_V(6); PG8_BAR;
    }
    for (;;) {
        const bool has_next = S.next(ui + 1, nxt);
        const char* nA = has_next ? (const char*)g.A + (size_t)nxt.pm * tstepA : cA;
        const char* nB = has_next ? (const char*)g.Bt + (size_t)((unsigned)nxt.e * g.bstride) + (size_t)nxt.pn * tstepB : cB;
#pragma unroll 1
        for (int t = 0; t < nt; t += 2) {
            const bool last = (t == nt - 2);
            const char* a1 = cA + (size_t)(t + 1) * kstep;
            const char* a2 = last ? nA : cA + (size_t)(t + 2) * kstep; const char* b2 = last ? nB : cB + (size_t)(t + 2) * kstep;
            const char* a3 = a2 + kstep; const char* b3 = b2 + kstep;
            if (last && has_next) S.a_ready(nxt);
            if constexpr (SP2) {
            PG8_LDB(B0, 0, 0); PG8_LDB(B1, 0, 1); PG8_SCHED; PG8_LDA(At, 0, 0); PG8_STAGE(PG8_SA(1, 1), a1 + hstepA, voffA);
            PG8_WAIT_V(8); PG8_WAIT_L(0); PG8_BAR; PG8_MMA(0, 0, At, B0); PG8_MMA(0, 1, At, B1); PG8_BAR; PG8_SCHED;
            PG8_LDA(At, 0, 1); PG8_STAGE(PG8_SB(0, 0), b2, voffB); PG8_STAGE(PG8_SB(0, 1), b2 + hstepB, voffB); PG8_STAGE(PG8_SA(0, 0), a2, voffA);
            PG8_WAIT_V(8); PG8_WAIT_L(0); PG8_BAR; PG8_MMA(1, 0, At, B0); PG8_MMA(1, 1, At, B1); PG8_BAR; PG8_SCHED;
            PG8_LDB(B0, 1, 0); PG8_LDB(B1, 1, 1); PG8_SCHED; PG8_LDA(At, 1, 0); PG8_STAGE(PG8_SA(0, 1), a2 + hstepA, voffA);
            PG8_WAIT_V(8); PG8_WAIT_L(0); PG8_BAR; PG8_MMA(0, 0, At, B0); PG8_MMA(0, 1, At, B1); PG8_BAR; PG8_SCHED;
            PG8_LDA(At, 1, 1); PG8_STAGE(PG8_SB(1, 0), b3, voffB); PG8_STAGE(PG8_SB(1, 1), b3 + hstepB, voffB); PG8_STAGE(PG8_SA(1, 0), a3, voffA);
            PG8_WAIT_V(8); PG8_WAIT_L(0); PG8_BAR; PG8_MMA(1, 0, At, B0); PG8_MMA(1, 1, At, B1); PG8_BAR; PG8_SCHED;
            } else {
            PG8_LDB(B0, 0, 0); PG8_SCHED; PG8_LDA(At, 0, 0); PG8_STAGE(PG8_SA(1, 1), a1 + hstepA, voffA);
            PG8_WAIT_V(10); PG8_WAIT_L(8); PG8_BAR; PG8_WAIT_L(0); PG8_MMA(0, 0, At, B0); PG8_BAR; PG8_SCHED;
            PG8_LDB(B1, 0, 1); PG8_STAGE(PG8_SB(0, 0), b2, voffB);
            PG8_WAIT_V(10); PG8_BAR; PG8_WAIT_L(0); PG8_MMA(0, 1, At, B1); PG8_BAR;
            PG8_LDA(At, 0, 1); PG8_STAGE(PG8_SA(0, 0), a2, voffA);
            PG8_WAIT_V(10); PG8_BAR; PG8_WAIT_L(0); PG8_MMA(1, 0, At, B0); PG8_BAR; PG8_SCHED;
            PG8_STAGE(PG8_SB(0, 1), b2 + hstepB, voffB);
            PG8_WAIT_V(10); PG8_BAR; PG8_MMA(1, 1, At, B1); PG8_BAR;
            PG8_LDB(B0, 1, 0); PG8_SCHED; PG8_LDA(At, 1, 0); PG8_STAGE(PG8_SA(0, 1), a2 + hstepA, voffA);
            PG8_WAIT_V(10); PG8_WAIT_L(8); PG8_BAR; PG8_WAIT_L(0); PG8_MMA(0, 0, At, B0); PG8_BAR; PG8_SCHED;
            PG8_LDB(B1, 1, 1); PG8_STAGE(PG8_SB(1, 0), b3, voffB);
            PG8_WAIT_V(10); PG8_BAR; PG8_WAIT_L(0); PG8_MMA(0, 1, At, B1); PG8_BAR;
            PG8_LDA(At, 1, 1); PG8_STAGE(PG8_SA(1, 0), a3, voffA);
            PG8_WAIT_V(10); PG8_BAR; PG8_WAIT_L(0); PG8_MMA(1, 0, At, B0); PG8_BAR; PG8_SCHED;
            PG8_STAGE(PG8_SB(1, 1), b3 + hstepB, voffB);
            PG8_WAIT_V(10); PG8_BAR; PG8_MMA(1, 1, At, B1); PG8_BAR;
            }
        }
        if constexpr (ALIGN_EPI) { if (wr == 0) PG8_BAR; }
        E(acc, cur, wr, wc, fr, fq, ui); S.done(cur);
        if (!has_next) break;
#pragma unroll
        for (int a = 0; a < 2; ++a)
#pragma unroll
            for (int b = 0; b < 2; ++b)
#pragma unroll
                for (int m = 0; m < 4; ++m)
#pragma unroll
                    for (int n = 0; n < 2; ++n) acc[a][b][m][n] = (f32x4){0.f, 0.f, 0.f, 0.f};
        cur = nxt; cA = nA; cB = nB; ++ui;
        if constexpr (ALIGN_EPI) { if (wr == 1) PG8_BAR; }
    }
    PG8_WAIT_V(0);
    if constexpr (!ALIGN_EPI) { if (wr == 0) PG8_BAR; }
    PG8_BAR;
#undef PG8_SA
#undef PG8_SB
#undef PG8_STAGE
#undef qvoffA
#undef qvoffB
#undef PG8_LDA
#undef PG8_LDB
#undef PG8_MMA
#undef PG8_CAT
#undef PG8_WAIT_V
#undef PG8_WAIT_L
#undef PG8_BAR
#undef PG8_SCHED
}

__device__ __forceinline__ float rstd_from_partials(const float* ssq, int row) {
    const f32x4* sp = (const f32x4*)(ssq + (size_t)row * 16);
    const f32x4 s0 = sp[0], s1 = sp[1], s2 = sp[2], s3 = sp[3];
    const f32x4 s = (s0 + s1) + (s2 + s3);
    return __builtin_amdgcn_rsqf(((s[0] + s[1]) + (s[2] + s[3])) * (1.0f / D) + EPS);
}
template <class Sched>
__device__ __forceinline__ void fill_rstd_table(const Sched& S, const float* ssq, LAS float* rt, int max_units) {
    int tid = threadIdx.x; asm volatile("" : "+v"(tid));
    const int half = tid >> 8, r = tid & 255;
#pragma unroll 1
    for (int i = 0; i < max_units; i += 2) { Unit u; if (S.next(i + half, u)) rt[(i + half) * BM + r] = rstd_from_partials(ssq, u.pm * BM + r); }
    __syncthreads();
}
__device__ __forceinline__ u32x4 pack8(const f32x4 a, const f32x4 b) { u32x4 w; w.x = cvt_pk_bf16(a[0], a[1]); w.y = cvt_pk_bf16(a[2], a[3]); w.z = cvt_pk_bf16(b[0], b[1]); w.w = cvt_pk_bf16(b[2], b[3]); return w; }

struct EpiG1 {
    static constexpr bool PERM = true;
    bf16_t* Z; float* gates; const LAS float* rt; const float* rope; const float* qw; const float* kw; int one_pm = 0;
    __device__ __forceinline__ void operator()(const f32x4 (&acc)[2][2][4][2], const Unit& u, int wr, int wc, int fr, int fq, int ui) const {
        const int row0 = u.pm * BM + wr * 64 + fr, pn = u.pn;
        const int kind = pn < 4 ? 0 : (pn < 8 ? 1 : (pn < 14 ? 2 : (pn < 23 ? 1 : (pn == 23 ? 3 : 4))));
        float rsv[8];
#pragma unroll
        for (int rg = 0; rg < 8; ++rg) rsv[rg] = rt[(one_pm ? 0 : ui) * BM + wr * 64 + fr + (rg >> 2) * HALF + (rg & 3) * 16];
        f32x4 nw[2][2];
        if (kind == 2) { const float* w = pn < 11 ? qw : kw;
#pragma unroll
            for (int bj = 0; bj < 2; ++bj) { nw[bj][0] = *(const f32x4*)(w + 32 * bj + 8 * fq); nw[bj][1] = *(const f32x4*)(w + 32 * bj + 8 * fq + 4); } }
#pragma unroll
        for (int ai = 0; ai < 2; ++ai) {
            f32x4 rcs[4], rsn[4];
            if (kind == 0) {
#pragma unroll
                for (int m = 0; m < 4; ++m) { const int pos = (row0 + ai * HALF + m * 16) & (SEQ - 1), i0 = 16 * wc + 4 * fq; rcs[m] = *(const f32x4*)(rope + pos * 64 + i0); rsn[m] = *(const f32x4*)(rope + SEQ * 64 + pos * 64 + i0); } }
#pragma unroll
            for (int m = 0; m < 4; ++m) {
                const int row = row0 + ai * HALF + m * 16;
                const float rs = rsv[ai * 4 + m];
                f32x4 v[2][2];
#pragma unroll
                for (int bj = 0; bj < 2; ++bj)
#pragma unroll
                    for (int n = 0; n < 2; ++n) v[bj][n] = acc[ai][bj][m][n] * rs;
                bf16_t* zrow = Z + (size_t)row * NZ;
                if (kind == 0) {
                    const f32x4 cs = rcs[m], sn = rsn[m];
#pragma unroll
                    for (int bj = 0; bj < 2; ++bj) {
                        const f32x4 a = v[bj][0], b = v[bj][1];
                        const f32x4 o0 = {a[0] * cs[0] - a[1] * sn[0], a[0] * sn[0] + a[1] * cs[0], a[2] * cs[1] - a[3] * sn[1], a[2] * sn[1] + a[3] * cs[1]};
                        const f32x4 o1 = {b[0] * cs[2] - b[1] * sn[2], b[0] * sn[2] + b[1] * cs[2], b[2] * cs[3] - b[3] * sn[3], b[2] * sn[3] + b[3] * cs[3]};
                        *(u32x4*)(zrow + pn * BM + bj * HALF + wc * 32 + fq * 8) = pack8(o0, o1);
                    }
                } else if (kind == 1) {
#pragma unroll
                    for (int bj = 0; bj < 2; ++bj) *(u32x4*)(zrow + pn * BM + bj * HALF + wc * 32 + fq * 8) = pack8(v[bj][0], v[bj][1]);
                } else if (kind == 2) {
                    float ss = 0.f;
#pragma unroll
                    for (int bj = 0; bj < 2; ++bj)
#pragma unroll
                        for (int n = 0; n < 2; ++n) { const f32x4 x = v[bj][n]; ss += (x[0] * x[0] + x[1] * x[1]) + (x[2] * x[2] + x[3] * x[3]); }
                    ss += __shfl_xor(ss, 16); ss += __shfl_xor(ss, 32);
                    const bool isq = pn < 11;
                    const float hr = __builtin_amdgcn_rsqf(ss * (1.0f / 64.0f) + EPS) * (isq ? 0.125f * LOG2E : 1.0f);
                    const int head = 4 * (pn - (isq ? 8 : 11)) + wc;
                    bf16_t* dst = zrow + (isq ? ZC_DQ : ZC_DK) + head * 64;
#pragma unroll
                    for (int bj = 0; bj < 2; ++bj) {
                        const int dim = 32 * bj + 8 * fq;
                        *(u32x4*)(dst + dim) = pack8(v[bj][0] * nw[bj][0] * hr, v[bj][1] * nw[bj][1] * hr);
                    }
                } else if (kind == 3) {
                    if (wc == 0 && fq == 0) { float* gp = gates + (size_t)row * 8; *(f32x4*)gp = v[0][0]; *(f32x4*)(gp + 4) = v[0][1]; }
                } else {
#pragma unroll
                    for (int bj = 0; bj < 2; ++bj) {
                        f32x4 a = v[bj][0], b = v[bj][1];
#pragma unroll
                        for (int e = 0; e < 4; ++e) { a[e] = sigmoidf_(a[e]); b[e] = sigmoidf_(b[e]); }
                        *(u32x4*)(zrow + pn * BM + bj * HALF + wc * 32 + fq * 8) = pack8(a, b);
                    }
                }
                asm volatile("" ::: "memory");
            }
        }
    }
};
struct EpiGate8 {
    static constexpr bool PERM = true;
    bf16_t* Z; const LAS float* rt; int one_pm = 0;
    __device__ __forceinline__ void operator()(const f32x4 (&acc)[2][2][4][2], const Unit& u, int wr, int wc, int fr, int fq, int ui) const {
        const int row0 = u.pm * BM + wr * 64 + fr;
        float rsv[8];
#pragma unroll
        for (int rg = 0; rg < 8; ++rg) rsv[rg] = rt[(one_pm ? 0 : ui) * BM + wr * 64 + fr + (rg >> 2) * HALF + (rg & 3) * 16];
#pragma unroll
        for (int ai = 0; ai < 2; ++ai)
#pragma unroll
            for (int m = 0; m < 4; ++m) {
                const int row = row0 + ai * HALF + m * 16;
                const float rs = rsv[ai * 4 + m];
                bf16_t* zp = Z + (size_t)row * NZ + u.pn * BM + wc * 32 + fq * 8;
#pragma unroll
                for (int bj = 0; bj < 2; ++bj) {
                    f32x4 a = acc[ai][bj][m][0] * rs, b = acc[ai][bj][m][1] * rs;
                    if (u.pn >= ZC_SG / BM) {
#pragma unroll
                        for (int e = 0; e < 4; ++e) { a[e] = sigmoidf_(a[e]); b[e] = sigmoidf_(b[e]); } }
                    *(u32x4*)(zp + bj * HALF) = pack8(a, b);
                }
                asm volatile("" ::: "memory");
            }
    }
};
struct EpiBranch {
    static constexpr bool PERM = true;
    bf16_t* Y; const bf16_t* Zg; int first;
    __device__ __forceinline__ void operator()(const f32x4 (&acc)[2][2][4][2], const Unit& u, int wr, int wc, int fr, int fq, int ui) const {
        const int row0 = u.pm * BM + wr * 64 + fr, col0 = u.pn * BM + wc * 32 + fq * 8;
#pragma unroll
        for (int ai = 0; ai < 2; ++ai) {
            u32x4 g[4][2], y[4][2];
#pragma unroll
            for (int m = 0; m < 4; ++m)
#pragma unroll
                for (int bj = 0; bj < 2; ++bj) g[m][bj] = __builtin_nontemporal_load((const u32x4*)(Zg + (size_t)(row0 + ai * HALF + m * 16) * NZ + col0 + bj * HALF));
            if (!first) {
#pragma unroll
                for (int m = 0; m < 4; ++m)
#pragma unroll
                    for (int bj = 0; bj < 2; ++bj) y[m][bj] = *(const u32x4*)(Y + (size_t)(row0 + ai * HALF + m * 16) * D + col0 + bj * HALF);
            }
#pragma unroll
            for (int m = 0; m < 4; ++m)
#pragma unroll
                for (int bj = 0; bj < 2; ++bj) {
                    const u32x4 gg = g[m][bj];
                    f32x4 a = acc[ai][bj][m][0], b = acc[ai][bj][m][1];
                    a[0] *= bf_lo(gg.x); a[1] *= bf_hi(gg.x); a[2] *= bf_lo(gg.y); a[3] *= bf_hi(gg.y);
                    b[0] *= bf_lo(gg.z); b[1] *= bf_hi(gg.z); b[2] *= bf_lo(gg.w); b[3] *= bf_hi(gg.w);
                    if (!first) { const u32x4 yy = y[m][bj];
                        a[0] += bf_lo(yy.x); a[1] += bf_hi(yy.x); a[2] += bf_lo(yy.y); a[3] += bf_hi(yy.y);
                        b[0] += bf_lo(yy.z); b[1] += bf_hi(yy.z); b[2] += bf_lo(yy.w); b[3] += bf_hi(yy.w); }
                    *(u32x4*)(Y + (size_t)(row0 + ai * HALF + m * 16) * D + col0 + bj * HALF) = pack8(a, b);
                }
            asm volatile("" ::: "memory");
        }
    }
};
struct EpiResid {
    static constexpr bool PERM = true;
    const bf16_t* base; float* out; bf16_t* xb; float* ssq; unsigned char* xb8; int ldx = D;
    __device__ __forceinline__ void operator()(const f32x4 (&acc)[2][2][4][2], const Unit& u, int wr, int wc, int fr, int fq, int ui) const {
        const int row0 = u.pm * BM + wr * 64 + fr, col0 = u.pn * BM + wc * 32 + fq * 8;
#pragma unroll
        for (int ai = 0; ai < 2; ++ai) {
            u32x4 bs[4][2];
#pragma unroll
            for (int m = 0; m < 4; ++m)
#pragma unroll
                for (int bj = 0; bj < 2; ++bj) bs[m][bj] = *(const u32x4*)(base + (size_t)(row0 + ai * HALF + m * 16) * D + col0 + bj * HALF);
#pragma unroll
            for (int m = 0; m < 4; ++m) {
                const int row = row0 + ai * HALF + m * 16; float ss = 0.f;
#pragma unroll
                for (int bj = 0; bj < 2; ++bj) {
                    const size_t o = (size_t)row * D + col0 + bj * HALF;
                    const u32x4 r = bs[m][bj];
                    f32x4 a = acc[ai][bj][m][0], b = acc[ai][bj][m][1];
                    a[0] += bf_lo(r.x); a[1] += bf_hi(r.x); a[2] += bf_lo(r.y); a[3] += bf_hi(r.y);
                    b[0] += bf_lo(r.z); b[1] += bf_hi(r.z); b[2] += bf_lo(r.w); b[3] += bf_hi(r.w);
                    if (out) { *(f32x4*)(out + o) = a; *(f32x4*)(out + o + 4) = b; }
                    *(u32x4*)(xb + (size_t)row * ldx + col0 + bj * HALF) = pack8(a, b);
                    if (xb8 && row < TG) { u32x2 w8; w8.x = cvt_pk4_fp8(a[0] * ACT8_SCALE, a[1] * ACT8_SCALE, a[2] * ACT8_SCALE, a[3] * ACT8_SCALE); w8.y = cvt_pk4_fp8(b[0] * ACT8_SCALE, b[1] * ACT8_SCALE, b[2] * ACT8_SCALE, b[3] * ACT8_SCALE); *(u32x2*)(xb8 + o) = w8; }
                    ss += ((a[0] * a[0] + a[1] * a[1]) + (a[2] * a[2] + a[3] * a[3])) + ((b[0] * b[0] + b[1] * b[1]) + (b[2] * b[2] + b[3] * b[3]));
                }
                ss += __shfl_xor(ss, 16); ss += __shfl_xor(ss, 32);
                if (fq == 0) ssq[(size_t)row * 16 + u.pn * 4 + wc] = ss;
            }
            asm volatile("" ::: "memory");
        }
    }
};
template <bool F8OUT> struct EpiSwiglu {
    static constexpr bool PERM = true;
    unsigned char* out; int ldo; const float* rsrc; const LAS float* rtl;
    __device__ __forceinline__ void operator()(const f32x4 (&acc)[2][2][4][2], const Unit& u, int wr, int wc, int fr, int fq, int ui) const {
        const int row0 = u.pm * BM + wr * 64 + fr, col = u.pn * HALF + wc * 32 + fq * 8;
        float rsv[8];
#pragma unroll
        for (int rg = 0; rg < 8; ++rg) { if constexpr (F8OUT) rsv[rg] = 1.0f; else rsv[rg] = rtl[ui * BM + wr * 64 + fr + (rg >> 2) * HALF + (rg & 3) * 16]; }
#pragma unroll
        for (int ai = 0; ai < 2; ++ai)
#pragma unroll
            for (int m = 0; m < 4; ++m) {
                const int row = row0 + ai * HALF + m * 16;
                const float rs = rsv[ai * 4 + m];
                f32x4 a, b;
#pragma unroll
                for (int e = 0; e < 4; ++e) { a[e] = siluf_(acc[ai][0][m][0][e] * rs) * (acc[ai][1][m][0][e] * rs); b[e] = siluf_(acc[ai][0][m][1][e] * rs) * (acc[ai][1][m][1][e] * rs); }
                if constexpr (F8OUT) { u32x2 w8; w8.x = cvt_pk4_fp8(a[0] * ACT8_SCALE, a[1] * ACT8_SCALE, a[2] * ACT8_SCALE, a[3] * ACT8_SCALE); w8.y = cvt_pk4_fp8(b[0] * ACT8_SCALE, b[1] * ACT8_SCALE, b[2] * ACT8_SCALE, b[3] * ACT8_SCALE); *(u32x2*)(out + (size_t)row * ldo + col) = w8; }
                else *(u32x4*)(out + ((size_t)row * ldo + col) * 2) = pack8(a, b);
                asm volatile("" ::: "memory");
            }
    }
};
struct EpiMoeDown {
    static constexpr bool PERM = true;
    bf16_t* YD; int first;
    __device__ __forceinline__ void operator()(const f32x4 (&acc)[2][2][4][2], const Unit& u, int wr, int wc, int fr, int fq, int ui) const {
        const int row0 = u.pm * BM + wr * 64 + fr, col0 = u.pn * BM + wc * 32 + fq * 8;
#pragma unroll
        for (int ai = 0; ai < 2; ++ai)
#pragma unroll
            for (int m = 0; m < 4; ++m) {
                const int row = row0 + ai * HALF + m * 16;
#pragma unroll
                for (int bj = 0; bj < 2; ++bj) {
                    bf16_t* yp = YD + (size_t)row * D + col0 + bj * HALF;
                    f32x4 a = acc[ai][bj][m][0], b = acc[ai][bj][m][1];
                    if (!first) { const u32x4 y = *(const u32x4*)yp;
                        a[0] += bf_lo(y.x); a[1] += bf_hi(y.x); a[2] += bf_lo(y.y); a[3] += bf_hi(y.y);
                        b[0] += bf_lo(y.z); b[1] += bf_hi(y.z); b[2] += bf_lo(y.w); b[3] += bf_hi(y.w); }
                    *(u32x4*)yp = pack8(a, b);
                }
                asm volatile("" ::: "memory");
            }
    }
};
}
constexpr size_t MiB = 1u << 20;
constexpr size_t WS_CTL = 0, CTL_ZERO_BYTES = 1 * MiB;
constexpr size_t WS_ROPE = 1 * MiB;
constexpr size_t WS_SSQ = 2 * MiB;
constexpr size_t WS_GATES = 4 * MiB;
constexpr size_t WS_MSC = 4 * MiB + 512 * 1024;
constexpr size_t WS_MNV = 4 * MiB + 576 * 1024;
constexpr size_t WS_TOKE = 5 * MiB;
constexpr size_t WS_TOKP = 5 * MiB + 128 * 1024;
constexpr size_t WS_TOKR = 5 * MiB + 256 * 1024;
constexpr size_t WS_TOKS = 5 * MiB + 384 * 1024;
constexpr size_t WS_ELIST = 6 * MiB;
constexpr size_t WS_TS = 7 * MiB;
constexpr size_t WS_SLOTRS = 7 * MiB + 4096;
constexpr size_t WS_RTAB = 566 * MiB;
constexpr size_t WS_WSMALL = 8 * MiB;
constexpr size_t WS_WIN = WS_WSMALL;
constexpr size_t WS_WBR = WS_WIN + 2 * (size_t)NZ * D * 2;
constexpr size_t WS_WOUT = WS_WBR + 2 * (size_t)D * OW * 2;
constexpr size_t WS_WUP = WS_WOUT + 2 * (size_t)D * D * 2;
constexpr size_t WS_WDN = WS_WUP + (size_t)2 * FF * D * 2;
constexpr size_t WS_Z = 70 * MiB;
constexpr size_t WS_O = 358 * MiB;
constexpr size_t WS_Y = 398 * MiB;
constexpr size_t WS_XB = 430 * MiB;
constexpr size_t WS_VT = 494 * MiB;
constexpr size_t WS_RU = 518 * MiB;
constexpr size_t WS_MU = 550 * MiB;
constexpr size_t WS_NEED = 582 * MiB;
constexpr size_t WS_XB8G = 566 * MiB;
constexpr size_t WS_A1 = WS_Z;
constexpr size_t WS_XB8 = WS_Z + 96 * MiB;
constexpr size_t WS_WMOE = 8 * MiB;
constexpr size_t WMOE_UP_BYTES = (size_t)2 * FFE * D, WMOE_E_BYTES = WMOE_UP_BYTES + (size_t)D * FFE;
constexpr size_t WS_XG = 92 * MiB;
constexpr size_t WS_YD = 158 * MiB;
constexpr size_t WS_AE = 290 * MiB;
static_assert(WS_WDN + (size_t)D * FF * 2 <= WS_Z && WS_Z + (size_t)TG * NZ * 2 <= WS_O && WS_O + (size_t)TG * OW * 2 <= WS_Y && WS_Y + (size_t)TG * D * 2 <= WS_XB, "ws map 1");
static_assert(WS_XB + (size_t)T * D * 2 <= WS_VT && WS_VT + (size_t)BG * 12 * 64 * SEQ * 2 <= WS_RU && WS_RU + (size_t)512 * 16384 * 4 <= WS_MU && WS_MU + (size_t)512 * 8192 * 4 <= WS_NEED, "ws map 2");
static_assert(WS_WMOE + NE * WMOE_E_BYTES <= WS_XG && WS_XG + (size_t)MAXSLOT * D <= WS_YD && WS_YD + (size_t)MAXSLOT * D * 2 <= WS_AE && WS_AE + (size_t)MAXSLOT * FFE <= WS_NEED, "ws map 3");
static_assert(WS_A1 + (size_t)T * FF * 2 <= WS_O, "ws map 4");
constexpr int CW_CNT = 64;
constexpr int CW_BAR = 4096;
constexpr int RING_BYTES = 131072, MISC_OFF = RING_BYTES, LDS_BYTES = 147456;
constexpr unsigned long long tl6(int a, int b, int c, int d, int e, int f, int g, int h, int i, int j) { return (unsigned long long)a | ((unsigned long long)b << 6) | ((unsigned long long)c << 12) | ((unsigned long long)d << 18) | ((unsigned long long)e << 24) | ((unsigned long long)f << 30) | ((unsigned long long)g << 36) | ((unsigned long long)h << 42) | ((unsigned long long)i << 48) | ((unsigned long long)j << 54); }
constexpr unsigned long long TL16_LO = tl6(0, 1, 2, 3, 4, 5, 6, 8, 9, 10), TL16_HI = tl6(11, 12, 13, 17, 18, 23, 0, 0, 0, 0);
constexpr unsigned long long TL20_LO = tl6(7, 14, 15, 16, 19, 20, 21, 22, 24, 25), TL20_HI = tl6(26, 27, 28, 29, 30, 31, 32, 33, 34, 35);
constexpr int RTAB_UNITS = 20;
constexpr int NPHASES = 32;

#define XB_TMO      128
#define XB_XCNT(j)  (256  + 64 * (j))
#define XB_XSUB(j)  (1280 + 64 * (j))
#define XB_XGEN(j)  (2304 + 64 * (j))
#define XB_TOP      3328
#define XB_TOPGEN   3392
#define XCD_BAR_WORDS 3456
#define XB_SPIN_CAP (1u << 18)
__device__ __forceinline__ unsigned xb_ld(unsigned* p)              { return __hip_atomic_load(p, __ATOMIC_RELAXED, __HIP_MEMORY_SCOPE_AGENT); }
__device__ __forceinline__ unsigned xb_add(unsigned* p, unsigned v) { return __hip_atomic_fetch_add(p, v, __ATOMIC_RELAXED, __HIP_MEMORY_SCOPE_AGENT); }
__device__ __forceinline__ unsigned xb_xcc_id() { return (unsigned)__builtin_amdgcn_s_getreg((3 << 11) | 20) & 0xFu; }
#define XB_SPIN(cond, bar) do { unsigned _sp = 0; while (cond) { __builtin_amdgcn_s_sleep(1); \
    if ((++_sp & 255u) == 0u) { if (xb_ld(&(bar)[XB_TMO])) break; if (_sp > XB_SPIN_CAP) { atomicAdd(&(bar)[XB_TMO], 1u); break; } } } } while (0)
struct XcdBarrier { unsigned* bar; unsigned x; volatile LAS unsigned* st; };
__device__ __forceinline__ XcdBarrier xcd_barrier_post(unsigned* bar, volatile LAS unsigned* st) {
    XcdBarrier b; b.bar = bar; b.x = xb_xcc_id(); b.st = st;
    if (threadIdx.x == 0) st[4] = xb_add(&bar[XB_XCNT(b.x)], 1u);
    return b;
}
__device__ __forceinline__ void xcd_barrier_complete(unsigned* bar, unsigned x, unsigned& nloc, unsigned& nx, unsigned& even) {
    const unsigned G = gridDim.x * gridDim.y * gridDim.z;
    unsigned sum, cnt, mine, ev, sp = 0u;
    for (;;) {
        sum = 0u; cnt = 0u; mine = 0u; ev = 1u;
#pragma unroll 1
        for (unsigned j = 0; j < 16; ++j) { const unsigned c = xb_ld(&bar[XB_XCNT(j)]); sum += c; cnt += (c > 0u) ? 1u : 0u; mine = (j == x) ? c : mine; ev &= (c == ((j < 8u) ? (G >> 3) : 0u)) ? 1u : 0u; }
        if (sum == G) break;
        __builtin_amdgcn_s_sleep(1);
        if ((++sp & 255u) == 0u) { if (xb_ld(&bar[XB_TMO])) break; if (sp > XB_SPIN_CAP) { atomicAdd(&bar[XB_TMO], 1u); break; } }
    }
    nloc = mine > 0u ? mine : 1u; nx = cnt > 0u ? cnt : 1u; even = (sum == G && (G & 7u) == 0u) ? ev : 0u;
}
__device__ __forceinline__ void xcd_barrier(const XcdBarrier& b) {
    asm volatile("s_waitcnt vmcnt(0)" ::: "memory");
    __syncthreads();
    if (threadIdx.x == 0) {
        unsigned* bar = b.bar;
        __builtin_amdgcn_s_waitcnt(0);
        unsigned nloc = b.st[0], nx = b.st[1];
        if (nloc == 0u) { unsigned even; xcd_barrier_complete(bar, b.x, nloc, nx, even); b.st[0] = nloc; b.st[1] = nx; b.st[2] = even; }
        const unsigned old = xb_add(&bar[XB_XSUB(b.x)], 1u);
        const unsigned gen = old / nloc;
        if (old + 1u == (gen + 1u) * nloc) {
            __builtin_amdgcn_fence(__ATOMIC_RELEASE, "agent");
            asm volatile("s_waitcnt vmcnt(0)" ::: "memory");
            const unsigned og = xb_add(&bar[XB_TOP], 1u);
            const unsigned tg = og / nx;
            if (og + 1u == (tg + 1u) * nx) xb_add(&bar[XB_TOPGEN], 1u);
            else XB_SPIN(xb_ld(&bar[XB_TOPGEN]) == tg, bar);
            __builtin_amdgcn_fence(__ATOMIC_ACQUIRE, "agent");
            xb_add(&bar[XB_XGEN(b.x)], 1u);
            asm volatile("s_waitcnt vmcnt(0)" ::: "memory");
        } else {
            XB_SPIN(xb_ld(&bar[XB_XGEN(b.x)]) == gen, bar);
            __builtin_amdgcn_fence(__ATOMIC_ACQUIRE, "agent");
            asm volatile("s_waitcnt vmcnt(0)" ::: "memory");
        }
    }
    __syncthreads();
}

#define XL_CNT(j) (8192 + 64 * (j))
__device__ __forceinline__ void xcd_local_barrier(unsigned* bar, unsigned x, unsigned nloc) {
    asm volatile("s_waitcnt vmcnt(0)" ::: "memory");
    __syncthreads();
    if (threadIdx.x == 0) {
        __builtin_amdgcn_s_waitcnt(0);
        const unsigned old = xb_add(&bar[XL_CNT(x)], 1u);
        const unsigned target = (old / nloc + 1u) * nloc;
        XB_SPIN(xb_ld(&bar[XL_CNT(x)]) < target, bar);
        __builtin_amdgcn_fence(__ATOMIC_ACQUIRE, "agent");
        asm volatile("s_waitcnt vmcnt(0)" ::: "memory");
    }
    __syncthreads();
}

struct Frame {
    LAS unsigned char* lds;
    unsigned char* ws;
    int tid, lane, wave, G, gw, NGW;
};
__device__ __forceinline__ float wave_sum(float v) {
#pragma unroll
    for (int o = 1; o < 64; o <<= 1) v += __shfl_xor(v, o);
    return v;
}
__device__ __forceinline__ float wave_max(float v) {
#pragma unroll
    for (int o = 1; o < 64; o <<= 1) v = fmaxf(v, __shfl_xor(v, o));
    return v;
}
__device__ __forceinline__ bf16x8 as_bf16x8(u32x4 v) { return __builtin_bit_cast(bf16x8, v); }
__device__ __forceinline__ f32x4 mfma16(bf16x8 a, bf16x8 b, f32x4 c) { return __builtin_amdgcn_mfma_f32_16x16x32_bf16(a, b, c, 0, 0, 0); }
__device__ __forceinline__ bf16x8 rowfrag(const LAS unsigned char* img, int rs, int row, int colbyte) { return *(const LAS bf16x8*)(img + row * rs + colbyte); }
__device__ __forceinline__ bf16x8 trfrag(const LAS unsigned char* img, int rs, int r0, int c0, int lane, int gs, int ts) {
    const int g = lane >> 4, q = (lane & 15) >> 2, p = lane & 3;
    const LAS unsigned char* a0 = img + (r0 + g * gs + q) * rs + (c0 + 4 * p) * 2;
    const s16x4 v0 = __builtin_amdgcn_ds_read_tr16_b64_v4i16((LAS s16x4*)a0);
    const s16x4 v1 = __builtin_amdgcn_ds_read_tr16_b64_v4i16((LAS s16x4*)(a0 + ts * rs));
    return (bf16x8){v0[0], v0[1], v0[2], v0[3], v1[0], v1[1], v1[2], v1[3]};
}
#define TR_NAT(img, rs, r0, c0, lane) trfrag(img, rs, r0, c0, lane, 8, 4)
#define TR_PERM(img, rs, r0, c0, lane) trfrag(img, rs, r0, c0, lane, 4, 16)

template <class M> __device__ __forceinline__ int dst_row(const M&, int n) { return n; }
template <bool F8, class Map>
__device__ __forceinline__ void convert_w(const Frame& F, int& woff, int ldw, int K, int N, void* dstv, int ldd, int kofs, const float* rowscale, const Map map) {
    const int nblk = N / 64, nitems = (K / 64) * nblk, lane = F.lane;
    int first = F.gw - woff; first += first < 0 ? F.NGW : 0; woff = (woff + nitems) % F.NGW;
    for (int item = first; item < nitems; item += F.NGW) {
        const int kb = item / nblk, nb = item % nblk, k0 = 64 * kb, n = 64 * nb + lane;
        const float* p; float s; map(n, p, s); const int dn = dst_row(map, n);
        float v[64];
        if (p) { const float* q = p + (size_t)k0 * ldw;
#pragma unroll
            for (int i = 0; i < 64; ++i) v[i] = __builtin_nontemporal_load(q + (size_t)i * ldw);
        } else {
#pragma unroll
            for (int i = 0; i < 64; ++i) v[i] = 0.f;
        }
        if (rowscale) {
#pragma unroll
            for (int i = 0; i < 64; ++i) v[i] *= rowscale[k0 + i] * s;
        } else {
#pragma unroll
            for (int i = 0; i < 64; ++i) v[i] *= s;
        }
        if constexpr (F8) {
            unsigned char* o = (unsigned char*)dstv + (size_t)dn * ldd + kofs + k0;
#pragma unroll
            for (int c16 = 0; c16 < 4; ++c16) { u32x4 w;
                w.x = cvt_pk4_fp8(v[16 * c16] * W8_SCALE, v[16 * c16 + 1] * W8_SCALE, v[16 * c16 + 2] * W8_SCALE, v[16 * c16 + 3] * W8_SCALE);
                w.y = cvt_pk4_fp8(v[16 * c16 + 4] * W8_SCALE, v[16 * c16 + 5] * W8_SCALE, v[16 * c16 + 6] * W8_SCALE, v[16 * c16 + 7] * W8_SCALE);
                w.z = cvt_pk4_fp8(v[16 * c16 + 8] * W8_SCALE, v[16 * c16 + 9] * W8_SCALE, v[16 * c16 + 10] * W8_SCALE, v[16 * c16 + 11] * W8_SCALE);
                w.w = cvt_pk4_fp8(v[16 * c16 + 12] * W8_SCALE, v[16 * c16 + 13] * W8_SCALE, v[16 * c16 + 14] * W8_SCALE, v[16 * c16 + 15] * W8_SCALE);
                *(u32x4*)(o + 16 * c16) = w; }
        } else {
        bf16_t* o = (bf16_t*)dstv + (size_t)dn * ldd + kofs + k0;
#pragma unroll
        for (int c8 = 0; c8 < 8; ++c8) { u32x4 w; w.x = cvt_pk_bf16(v[8 * c8], v[8 * c8 + 1]); w.y = cvt_pk_bf16(v[8 * c8 + 2], v[8 * c8 + 3]); w.z = cvt_pk_bf16(v[8 * c8 + 4], v[8 * c8 + 5]); w.w = cvt_pk_bf16(v[8 * c8 + 6], v[8 * c8 + 7]);
            *(u32x4*)(o + 8 * c8) = w; }
        }
    }
}
struct MapIdent { const float* W; __device__ __forceinline__ void operator()(int n, const float*& p, float& s) const { p = W + n; s = 1.f; } };
struct MapWin { const float* W;
    __device__ __forceinline__ void operator()(int n, const float*& p, float& s) const {
        int src; s = 1.f;
        if (n < 1024) { const int seg = n >> 9, h = (n & 511) >> 7, jp = n & 127; src = seg * 512 + h * 128 + (jp >> 1) + 64 * (jp & 1); if (seg) s = 0.08838834764831845f; }
        else if (n >= 2048 && n < 3584) { const int nl = n - 2048, seg = nl / 768, nl2 = nl % 768, t = nl2 >> 8, c = nl2 & 255, bj = c >> 7, wc = (c & 127) >> 5, j = c & 31; src = 2048 + seg * 768 + (4 * t + wc) * 64 + 32 * bj + j; }
        else if (n < 5888) src = n;
        else if (n < 6144) src = (n - 5888 < 8) ? n : -1;
        else src = n - 248;
        p = src >= 0 ? W + src : nullptr;
    } };
struct MapWinGate { const float* W; __device__ __forceinline__ void operator()(int n, const float*& p, float& s) const { p = W + (6144 - 248) + n; s = 1.f; } };
struct MapWinSel { const float* W; unsigned long long lo, hi;
    __device__ __forceinline__ int row(int n) const { const int k = n >> 8; const unsigned long long w = k < 10 ? lo : hi; return (int)((w >> (6 * (k < 10 ? k : k - 10))) & 63ull) * 256 + (n & 255); }
    __device__ __forceinline__ void operator()(int n, const float*& p, float& s) const { MapWin{W}(row(n), p, s); } };
__device__ __forceinline__ int dst_row(const MapWinSel& m, int n) { return m.row(n); }
struct MapGateUp { const float* Wg; const float* Wu;
    __device__ __forceinline__ void operator()(int n, const float*& p, float& s) const { const int pn = n >> 8, c = n & 255; p = Wg + (ptrdiff_t)(c >> 7) * (Wu - Wg) + pn * 128 + (c & 127); s = 1.f; } };

__device__ __forceinline__ void p0_rows(const Frame& F, const float* x) {
    bf16_t* xb = (bf16_t*)(F.ws + WS_XB); float* ssq = (float*)(F.ws + WS_SSQ);
    for (int m0 = F.gw; m0 < T; m0 += 4 * F.NGW) {
        f32x4 v[4][4];
#pragma unroll
        for (int q = 0; q < 4; ++q) { const int m = m0 + q * F.NGW < T ? m0 + q * F.NGW : m0; const f32x4* xr = (const f32x4*)(x + (size_t)m * D) + F.lane;
#pragma unroll
            for (int j = 0; j < 4; ++j) v[q][j] = __builtin_nontemporal_load(xr + 64 * j); }
#pragma unroll
        for (int q = 0; q < 4; ++q) { const int m = m0 + q * F.NGW; if (m >= T) break;
            float s = 0.f;
#pragma unroll
            for (int j = 0; j < 4; ++j) s += (v[q][j][0] * v[q][j][0] + v[q][j][1] * v[q][j][1]) + (v[q][j][2] * v[q][j][2] + v[q][j][3] * v[q][j][3]);
            s = wave_sum(s);
            u32x2* o8 = (u32x2*)(xb + (size_t)m * D) + F.lane;
#pragma unroll
            for (int j = 0; j < 4; ++j) { u32x2 w; w.x = cvt_pk_bf16(v[q][j][0], v[q][j][1]); w.y = cvt_pk_bf16(v[q][j][2], v[q][j][3]); o8[64 * j] = w; }
            if (F.lane < 16) ssq[(size_t)m * 16 + F.lane] = F.lane == 0 ? s : 0.f;
            if (m < TG) { unsigned* o4 = (unsigned*)(F.ws + WS_XB8G + (size_t)m * D) + F.lane;
#pragma unroll
                for (int j = 0; j < 4; ++j) o4[64 * j] = cvt_pk4_fp8(v[q][j][0] * ACT8_SCALE, v[q][j][1] * ACT8_SCALE, v[q][j][2] * ACT8_SCALE, v[q][j][3] * ACT8_SCALE); }
        }
    }
}
__device__ __forceinline__ void p0_rope(const Frame& F) {
    float* rope = (float*)(F.ws + WS_ROPE);
    for (int i = F.gw * 64 + F.lane; i < SEQ * 64; i += F.NGW * 64) {
        const int pos = i >> 6, k = i & 63;
        const float inv = powf(10000.0f, -(float)k / 64.0f);
        const float ang = (float)pos * inv;
        double rev = (double)ang * 0.15915494309189535; rev -= floor(rev);
        rope[i] = __builtin_amdgcn_cosf((float)rev); rope[SEQ * 64 + i] = __builtin_amdgcn_sinf((float)rev);
    }
}
constexpr int RS128 = 272, RS64 = 144;
struct LayerP {
    const float *ret_norm_w, *da_qw, *da_kw, *conv_w, *i_bias, *f_bias, *ml_norm_w;
};
__device__ __forceinline__ float ret_log2gamma(int h) { return log2f(1.0f - exp2f(-5.0f - (float)h)); }

template <int NC>
__device__ __forceinline__ void load_tile(const Frame& F, const bf16_t* g, int ldg, LAS unsigned char* img, int rs) {
    constexpr int PPR = NC / 8, NP = 128 * PPR;
    u32x4 t[NP / 512];
#pragma unroll
    for (int i = 0; i < NP / 512; ++i) { const int pc = F.tid + 512 * i, r = pc / PPR, ch = pc % PPR; t[i] = *(const u32x4*)(g + (size_t)r * ldg + ch * 8); }
#pragma unroll
    for (int i = 0; i < NP / 512; ++i) { const int pc = F.tid + 512 * i, r = pc / PPR, ch = pc % PPR; *(LAS u32x4*)(img + r * rs + ch * 16) = t[i]; }
}
template <int NC>
__device__ __forceinline__ void load_tile_scaled(const Frame& F, const bf16_t* g, int ldg, LAS unsigned char* img, int rs, const LAS float* sc) {
    constexpr int PPR = NC / 8, NP = 128 * PPR;
    u32x4 t[NP / 512];
#pragma unroll
    for (int i = 0; i < NP / 512; ++i) { const int pc = F.tid + 512 * i, r = pc / PPR, ch = pc % PPR; t[i] = *(const u32x4*)(g + (size_t)r * ldg + ch * 8); }
#pragma unroll
    for (int i = 0; i < NP / 512; ++i) { const int pc = F.tid + 512 * i, r = pc / PPR, ch = pc % PPR;
        const u32x4 v = t[i]; const float s = sc[r];
        u32x4 o; o.x = cvt_pk_bf16(bf_lo(v.x) * s, bf_hi(v.x) * s); o.y = cvt_pk_bf16(bf_lo(v.y) * s, bf_hi(v.y) * s); o.z = cvt_pk_bf16(bf_lo(v.z) * s, bf_hi(v.z) * s); o.w = cvt_pk_bf16(bf_lo(v.w) * s, bf_hi(v.w) * s);
        *(LAS u32x4*)(img + r * rs + ch * 16) = o; }
}
template <int NC>
__device__ __forceinline__ void load_tile_f32(const Frame& F, const float* g, LAS unsigned char* img, int rs) {
    constexpr int PPR = NC / 8, NP = 128 * PPR;
    f32x4 t[NP / 512][2];
#pragma unroll
    for (int i = 0; i < NP / 512; ++i) { const int pc = F.tid + 512 * i, r = pc / PPR, ch = pc % PPR; t[i][0] = *(const f32x4*)(g + (size_t)r * NC + ch * 8); t[i][1] = *(const f32x4*)(g + (size_t)r * NC + ch * 8 + 4); }
#pragma unroll
    for (int i = 0; i < NP / 512; ++i) { const int pc = F.tid + 512 * i, r = pc / PPR, ch = pc % PPR; *(LAS u32x4*)(img + r * rs + ch * 16) = pg8::pack8(t[i][0], t[i][1]); }
}
__device__ __forceinline__ u32x4 conv8(const bf16_t* Z, int row, int col, const float* cw, float scale) {
    const int pos = row & (SEQ - 1);
    float acc[8];
#pragma unroll
    for (int e = 0; e < 8; ++e) acc[e] = 0.f;
    u32x4 vv[4]; f32x4 ww[4][2];
#pragma unroll
    for (int i = 0; i < 4; ++i) { const int back = (pos - 3 + i >= 0) ? 3 - i : 0;
        vv[i] = *(const u32x4*)(Z + (size_t)(row - back) * NZ + col); ww[i][0] = *(const f32x4*)(cw + i * 512); ww[i][1] = *(const f32x4*)(cw + i * 512 + 4); }
#pragma unroll
    for (int i = 0; i < 4; ++i) {
        const float on = (pos - 3 + i >= 0) ? 1.0f : 0.0f;
        const u32x4 v = vv[i]; const f32x4 w0 = ww[i][0] * on, w1 = ww[i][1] * on;
        acc[0] += bf_lo(v.x) * w0[0]; acc[1] += bf_hi(v.x) * w0[1]; acc[2] += bf_lo(v.y) * w0[2]; acc[3] += bf_hi(v.y) * w0[3];
        acc[4] += bf_lo(v.z) * w1[0]; acc[5] += bf_hi(v.z) * w1[1]; acc[6] += bf_lo(v.w) * w1[2]; acc[7] += bf_hi(v.w) * w1[3];
    }
#pragma unroll
    for (int e = 0; e < 8; ++e) acc[e] = siluf_(acc[e]) * scale;
    u32x4 o; o.x = cvt_pk_bf16(acc[0], acc[1]); o.y = cvt_pk_bf16(acc[2], acc[3]); o.z = cvt_pk_bf16(acc[4], acc[5]); o.w = cvt_pk_bf16(acc[6], acc[7]);
    return o;
}

struct Conv8Rows { u32x4 v[4]; };
struct Conv8W { f32x4 w[4][2]; };
__device__ __forceinline__ Conv8Rows conv8_rows(const bf16_t* Z, int row, int col) {
    const int pos = row & (SEQ - 1); Conv8Rows r;
#pragma unroll
    for (int i = 0; i < 4; ++i) { const int back = (pos - 3 + i >= 0) ? 3 - i : 0; r.v[i] = *(const u32x4*)(Z + (size_t)(row - back) * NZ + col); }
    return r;
}
__device__ __forceinline__ Conv8W conv8_weights(const float* cw) { Conv8W w;
#pragma unroll
    for (int i = 0; i < 4; ++i) { w.w[i][0] = *(const f32x4*)(cw + i * 512); w.w[i][1] = *(const f32x4*)(cw + i * 512 + 4); }
    return w;
}
__device__ __forceinline__ u32x4 conv8_finish(const Conv8Rows& r, const Conv8W& w, int row, float scale) {
    const int pos = row & (SEQ - 1);
    float acc[8];
#pragma unroll
    for (int e = 0; e < 8; ++e) acc[e] = 0.f;
#pragma unroll
    for (int i = 0; i < 4; ++i) {
        const float on = (pos - 3 + i >= 0) ? 1.0f : 0.0f;
        const u32x4 v = r.v[i]; const f32x4 w0 = w.w[i][0] * on, w1 = w.w[i][1] * on;
        acc[0] += bf_lo(v.x) * w0[0]; acc[1] += bf_hi(v.x) * w0[1]; acc[2] += bf_lo(v.y) * w0[2]; acc[3] += bf_hi(v.y) * w0[3];
        acc[4] += bf_lo(v.z) * w1[0]; acc[5] += bf_hi(v.z) * w1[1]; acc[6] += bf_lo(v.w) * w1[2]; acc[7] += bf_hi(v.w) * w1[3];
    }
#pragma unroll
    for (int e = 0; e < 8; ++e) acc[e] = siluf_(acc[e]) * scale;
    u32x4 o; o.x = cvt_pk_bf16(acc[0], acc[1]); o.y = cvt_pk_bf16(acc[2], acc[3]); o.z = cvt_pk_bf16(acc[4], acc[5]); o.w = cvt_pk_bf16(acc[6], acc[7]);
    return o;
}

__device__ __forceinline__ void ret_A(const Frame& F, int unit) {
    const int bl = unit >> 6, h = (unit >> 4) & 3, n = unit & 15, row0 = bl * SEQ + n * 128;
    const bf16_t* Z = (const bf16_t*)(F.ws + WS_Z);
    LAS unsigned char* Kimg = F.lds; LAS unsigned char* Vimg = F.lds + 128 * RS128; LAS float* sc = (LAS float*)(F.lds + 2 * 128 * RS128);
    const float lg = ret_log2gamma(h);
    if (F.tid < 128) sc[F.tid] = exp2f(lg * (float)(127 - F.tid));
    __syncthreads();
    load_tile<128>(F, Z + (size_t)row0 * NZ + ZC_RK + h * 128, NZ, Kimg, RS128);
    load_tile_scaled<128>(F, Z + (size_t)row0 * NZ + ZC_RV + h * 128, NZ, Vimg, RS128, sc);
    __syncthreads();
    const int w = F.wave, lane = F.lane, fr = lane & 15, fq = lane >> 4;
    bf16x8 a[4];
#pragma unroll
    for (int ks = 0; ks < 4; ++ks) a[ks] = TR_NAT(Kimg, RS128, 32 * ks, 16 * w, lane);
    bf16_t* U = (bf16_t*)(F.ws + WS_RU) + (size_t)unit * 16384;
#pragma unroll
    for (int dvt = 0; dvt < 8; ++dvt) {
        f32x4 acc = {0.f, 0.f, 0.f, 0.f};
#pragma unroll
        for (int ks = 0; ks < 4; ++ks) acc = mfma16(a[ks], TR_NAT(Vimg, RS128, 32 * ks, 16 * dvt, lane), acc);
        { u32x2 o; o.x = cvt_pk_bf16(acc[0], acc[1]); o.y = cvt_pk_bf16(acc[2], acc[3]); *(u32x2*)(U + (16 * dvt + fr) * 128 + 16 * w + 4 * fq) = o; }
    }
    __syncthreads();
}
__device__ __forceinline__ void ml_gates(const Frame& F, const LayerP& P, int row0, int h, LAS float* ig, LAS float* bc, LAS float* lf) {
    const float* gates = (const float*)(F.ws + WS_GATES);
    float s = 0.f;
    if (F.tid < 128) {
        const float ip = gates[(size_t)(row0 + F.tid) * 8 + h] + P.i_bias[h];
        const float fp = gates[(size_t)(row0 + F.tid) * 8 + 4 + h] + P.f_bias[h];
        ig[F.tid] = ip; s = fminf(fp, 0.f) - log1pf(__expf(-fabsf(fp)));
#pragma unroll
        for (int o = 1; o < 64; o <<= 1) { const float t = __shfl_up(s, o); if (F.lane >= o) s += t; }
        if (F.tid == 63) lf[0] = s;
    }
    __syncthreads();
    if (F.tid < 128) bc[F.tid] = s + (F.tid >= 64 ? lf[0] : 0.f);
    __syncthreads();
}
__device__ __forceinline__ void ml_A(const Frame& F, const LayerP& P, int unit) {
    const int bl = unit >> 6, h = (unit >> 4) & 3, n = unit & 15, row0 = bl * SEQ + n * 128;
    const bf16_t* Z = (const bf16_t*)(F.ws + WS_Z);
    LAS unsigned char* Kimg = F.lds; LAS unsigned char* Vimg = F.lds + 128 * RS64;
    LAS float* ig = (LAS float*)(F.lds + 128 * RS64 + 128 * RS128); LAS float* bc = ig + 128; LAS float* wt = bc + 128; LAS float* red = wt + 128;
    const int kch = F.tid & 7;
    const Conv8W kw8 = conv8_weights(P.conv_w + 256 + h * 64 + kch * 8);
    Conv8Rows kr[2]; u32x4 vraw[4];
#pragma unroll
    for (int i = 0; i < 2; ++i) kr[i] = conv8_rows(Z, row0 + ((F.tid + 512 * i) >> 3), ZC_MK + h * 64 + kch * 8);
#pragma unroll
    for (int i = 0; i < 4; ++i) { const int pc = F.tid + 512 * i, r = pc >> 4, ch = pc & 15; vraw[i] = *(const u32x4*)(Z + (size_t)(row0 + r) * NZ + ZC_MV + h * 128 + ch * 8); }
    ml_gates(F, P, row0, h, ig, bc, wt);
    const float an = bc[127];
    if (F.tid < 64) { float v = fmaxf(an - bc[F.tid] + ig[F.tid], an - bc[F.tid + 64] + ig[F.tid + 64]); v = wave_max(v); if (F.tid == 0) red[0] = v; }
    __syncthreads();
    const float cn = red[0];
    if (F.tid < 128) wt[F.tid] = __expf(an - bc[F.tid] + ig[F.tid] - cn);
#pragma unroll
    for (int i = 0; i < 2; ++i) { const int pc = F.tid + 512 * i, r = pc >> 3;
        *(LAS u32x4*)(Kimg + r * RS64 + kch * 16) = conv8_finish(kr[i], kw8, row0 + r, 0.125f); }
    __syncthreads();
#pragma unroll
    for (int i = 0; i < 4; ++i) { const int pc = F.tid + 512 * i, r = pc >> 4, ch = pc & 15; const u32x4 v = vraw[i]; const float s = wt[r];
        u32x4 o; o.x = cvt_pk_bf16(bf_lo(v.x) * s, bf_hi(v.x) * s); o.y = cvt_pk_bf16(bf_lo(v.y) * s, bf_hi(v.y) * s); o.z = cvt_pk_bf16(bf_lo(v.z) * s, bf_hi(v.z) * s); o.w = cvt_pk_bf16(bf_lo(v.w) * s, bf_hi(v.w) * s);
        *(LAS u32x4*)(Vimg + r * RS128 + ch * 16) = o; }
    __syncthreads();
    const int w = F.wave, lane = F.lane, fr = lane & 15, fq = lane >> 4, dkt = w & 3;
    bf16x8 a[4];
#pragma unroll
    for (int ks = 0; ks < 4; ++ks) a[ks] = TR_NAT(Kimg, RS64, 32 * ks, 16 * dkt, lane);
    bf16_t* U = (bf16_t*)(F.ws + WS_MU) + (size_t)unit * 8192;
#pragma unroll
    for (int d4 = 0; d4 < 4; ++d4) { const int dvt = (w >> 2) * 4 + d4;
        f32x4 acc = {0.f, 0.f, 0.f, 0.f};
#pragma unroll
        for (int ks = 0; ks < 4; ++ks) acc = mfma16(a[ks], TR_NAT(Vimg, RS128, 32 * ks, 16 * dvt, lane), acc);
        { u32x2 o; o.x = cvt_pk_bf16(acc[0], acc[1]); o.y = cvt_pk_bf16(acc[2], acc[3]); *(u32x2*)(U + (16 * dvt + fr) * 64 + 16 * dkt + 4 * fq) = o; }
    }
    { const int dk = F.tid & 63, part = F.tid >> 6; float s = 0.f;
#pragma unroll
        for (int j = 0; j < 16; ++j) s += wt[part * 16 + j] * bf2f(*(const LAS bf16_t*)(Kimg + (part * 16 + j) * RS64 + dk * 2));
        red[64 + F.tid] = s; }
    __syncthreads();
    if (F.tid < 64) { float s = 0.f;
#pragma unroll
        for (int p = 0; p < 8; ++p) s += red[64 + p * 64 + F.tid];
        ((float*)(F.ws + WS_MNV))[(size_t)unit * 64 + F.tid] = s; }
    if (F.tid == 0) { float* msc = (float*)(F.ws + WS_MSC) + (size_t)unit * 4; msc[0] = an; msc[1] = cn; }
    __syncthreads();
}
__device__ __forceinline__ void vt_A(const Frame& F, int unit) {
    const int bl = unit / 96, head = (unit / 8) % 12, blk = unit & 7, r = head < 4 ? 1 : (head < 8 ? 4 : 16), rsh = head < 4 ? 0 : (head < 8 ? 2 : 4);
    const bf16_t* Z = (const bf16_t*)(F.ws + WS_Z);
    LAS unsigned char* img = F.lds;
    u32x4 tv[4];
#pragma unroll
    for (int i = 0; i < 4; ++i) { const int pc = F.tid + 512 * i, rr = pc >> 3, ch = pc & 7; tv[i] = *(const u32x4*)(Z + (size_t)(bl * SEQ + blk * 256 + rr) * NZ + ZC_DV + head * 64 + ch * 8); }
#pragma unroll
    for (int i = 0; i < 4; ++i) { const int pc = F.tid + 512 * i, rr = pc >> 3, ch = pc & 7; *(LAS u32x4*)(img + rr * RS64 + ch * 16) = tv[i]; }
    __syncthreads();
    bf16_t* VT = (bf16_t*)(F.ws + WS_VT) + (size_t)(bl * 12 + head) * 64 * SEQ;
    const int g4r = 64 >> rsh;
#pragma unroll
    for (int i = 0; i < 4; ++i) { const int pc = F.tid + 512 * i, pg = pc >> 5, d2 = pc & 31, rho = pg / g4r, p4 = pg % g4r;
        unsigned short v[8];
#pragma unroll
        for (int dd = 0; dd < 2; ++dd)
#pragma unroll
            for (int e = 0; e < 4; ++e) v[dd * 4 + e] = *(const LAS bf16_t*)(img + (((p4 * 4 + e) << rsh) + rho) * RS64 + (2 * d2 + dd) * 2);
        u32x4 o; o.x = v[0] | ((unsigned)v[1] << 16); o.y = v[2] | ((unsigned)v[3] << 16); o.z = v[4] | ((unsigned)v[5] << 16); o.w = v[6] | ((unsigned)v[7] << 16);
        const int pos4 = ((rho * (SEQ >> rsh) + ((blk * 256) >> rsh)) >> 2) + p4;
        *(u32x4*)(VT + ((size_t)pos4 * 64 + 2 * d2) * 4) = o; }
    __syncthreads();
}
__device__ __forceinline__ void scan_B(const Frame& F, int c) {
    const int gt = (c >> 3) * 512 + F.tid, NT = (F.G >> 3) * 512, bl = c & 7;
    for (int j = gt; j < 4 * 4096; j += NT) { const int h = j >> 12, idx = j & 4095, bh = bl * 4 + h;
        const float cd = exp2f(128.0f * ret_log2gamma(h));
        u32x2* p = (u32x2*)(F.ws + WS_RU) + (size_t)bh * 16 * 4096 + idx; f32x4 s = {0.f, 0.f, 0.f, 0.f};
        u32x2 u[16];
#pragma unroll
        for (int n = 0; n < 16; ++n) u[n] = p[(size_t)n * 4096];
#pragma unroll
        for (int n = 0; n < 16; ++n) { u32x2 o; o.x = cvt_pk_bf16(s[0], s[1]); o.y = cvt_pk_bf16(s[2], s[3]); p[(size_t)n * 4096] = o;
            const f32x4 uf = {bf_lo(u[n].x), bf_hi(u[n].x), bf_lo(u[n].y), bf_hi(u[n].y)}; s = s * cd + uf; } }
    for (int j = gt; j < 4 * 2064; j += NT) { const int bh = bl * 4 + j / 2064, idx = j % 2064;
        float* msc = (float*)(F.ws + WS_MSC) + (size_t)bh * 16 * 4;
        const bool isC = idx < 2048;
        u32x2* pb = (u32x2*)(F.ws + WS_MU) + (size_t)bh * 16 * 2048 + (isC ? idx : 0); f32x4* pf = (f32x4*)(F.ws + WS_MNV) + (size_t)bh * 16 * 16 + (isC ? 0 : idx - 2048);
        f32x4 s = {0.f, 0.f, 0.f, 0.f}; float mm = 0.f;
        f32x4 u[16]; float anv[16], cnv[16];
        if (isC) {
#pragma unroll
            for (int n = 0; n < 16; ++n) { const u32x2 r = pb[(size_t)n * 2048]; u[n] = (f32x4){bf_lo(r.x), bf_hi(r.x), bf_lo(r.y), bf_hi(r.y)}; }
        } else {
#pragma unroll
            for (int n = 0; n < 16; ++n) u[n] = pf[(size_t)n * 16];
        }
#pragma unroll
        for (int n = 0; n < 16; ++n) { anv[n] = msc[n * 4]; cnv[n] = msc[n * 4 + 1]; }
#pragma unroll
        for (int n = 0; n < 16; ++n) { const float an = anv[n], cn = cnv[n]; const float mn = fmaxf(an + mm, cn), f1 = __expf(an + mm - mn), f2 = __expf(cn - mn);
            if (isC) { u32x2 o; o.x = cvt_pk_bf16(s[0], s[1]); o.y = cvt_pk_bf16(s[2], s[3]); pb[(size_t)n * 2048] = o; } else pf[(size_t)n * 16] = s;
            s = s * f1 + u[n] * f2;
            if (idx == 0) msc[n * 4 + 2] = mm;
            mm = mn; } }
}
__device__ __forceinline__ void attn_B(const Frame& F, const LayerP& P, int unit) {
    const int bl = unit >> 5, j = (unit >> 3) & 3, blk = unit & 7;
    const bf16_t* Z = (const bf16_t*)(F.ws + WS_Z);
    LAS float* Oacc = (LAS float*)F.lds;
    LAS float* Lacc = Oacc + 256 * 68;
    const int w = F.wave, lane = F.lane, fr = lane & 15, fq = lane >> 4;
    const float shift = wave_max(fabsf(P.da_qw[lane] * P.da_kw[lane])) * 8.0f * LOG2E;
    for (int g = 0; g < 3; ++g) {
        const int head = 4 * g + j, rsh = 2 * g, r = 1 << rsh, Lr = SEQ >> rsh;
        const bf16_t* VT = (const bf16_t*)(F.ws + WS_VT) + (size_t)(bl * 12 + head) * 64 * SEQ;
        for (int it2 = 0; it2 < 2; ++it2) {
            const int it = w + 8 * it2, ipr = 16 >> rsh, rho = it / ipr, qt = it % ipr;
            const int i0 = ((blk * 256) >> rsh) + qt * 16;
            const int tq = ((i0 + fr) << rsh) + rho;
            const bf16_t* qp = Z + (size_t)(bl * SEQ + tq) * NZ + ZC_DQ + head * 64 + 8 * fq;
            const bf16x8 q0 = *(const bf16x8*)qp, q1 = *(const bf16x8*)(qp + 32);
            f32x4 o[4]; float lsum = 0.f;
#pragma unroll
            for (int dt = 0; dt < 4; ++dt) o[dt] = (f32x4){0.f, 0.f, 0.f, 0.f};
            const int kt_lo = i0 >= 128 ? 0 : (128 - i0) >> 4;
            const bf16_t* kbase = Z + (size_t)(bl * SEQ + rho) * NZ + ZC_DK + head * 64 + 8 * fq;
            bf16x8 kf[9][2];
#pragma unroll
            for (int kt = 0; kt < 9; ++kt) { int ik = i0 - 128 + 16 * kt + fr; ik = ik < 0 ? 0 : ik;
                const bf16_t* kp = kbase + (size_t)(ik << rsh) * NZ; kf[kt][0] = *(const bf16x8*)kp; kf[kt][1] = *(const bf16x8*)(kp + 32); }
            u32x2 vf[5][4][2];
#pragma unroll
            for (int ks = 0; ks < 5; ++ks) {
                int ik0 = i0 - 128 + 32 * ks + 4 * fq, ik1 = ik0 + 16;
                ik0 = ik0 < 0 ? 0 : ik0; ik1 = (ks == 4) ? ik0 : (ik1 < 0 ? 0 : ik1);
#pragma unroll
                for (int dt = 0; dt < 4; ++dt) { const bf16_t* vp = VT + (size_t)(16 * dt + fr) * 4;
                    vf[ks][dt][0] = *(const u32x2*)(vp + (size_t)((rho * Lr + ik0) >> 2) * 256); vf[ks][dt][1] = *(const u32x2*)(vp + (size_t)((rho * Lr + ik1) >> 2) * 256); }
            }
#pragma unroll
            for (int ks = 0; ks < 5; ++ks) {
                if (2 * ks + 1 < kt_lo) continue;
                u32x2 pp[2];
#pragma unroll
                for (int t = 0; t < 2; ++t) {
                    const int kt = 2 * ks + t;
                    float p[4] = {0.f, 0.f, 0.f, 0.f};
                    if (kt < 9) {
                        f32x4 s = {-shift, -shift, -shift, -shift};
                        s = mfma16(kf[kt < 9 ? kt : 8][0], q0, s); s = mfma16(kf[kt < 9 ? kt : 8][1], q1, s);
                        const bool tv = kt >= kt_lo;
#pragma unroll
                        for (int e = 0; e < 4; ++e) { const int kj = 16 * kt + 4 * fq + e;
                            const bool ok = tv && kj >= fr && kj <= 128 + fr;
                            p[e] = ok ? fast_exp2(s[e]) : 0.f; lsum += p[e]; }
                    }
                    pp[t].x = cvt_pk_bf16(p[0], p[1]); pp[t].y = cvt_pk_bf16(p[2], p[3]);
                }
                const bf16x8 pb = as_bf16x8((u32x4){pp[0].x, pp[0].y, pp[1].x, pp[1].y});
#pragma unroll
                for (int dt = 0; dt < 4; ++dt) o[dt] = mfma16(as_bf16x8((u32x4){vf[ks][dt][0].x, vf[ks][dt][0].y, vf[ks][dt][1].x, vf[ks][dt][1].y}), pb, o[dt]);
            }
            lsum += __shfl_xor(lsum, 16); lsum += __shfl_xor(lsum, 32);
            const int tl = tq - blk * 256;
#pragma unroll
            for (int dt = 0; dt < 4; ++dt) { LAS f32x4* op = (LAS f32x4*)(Oacc + tl * 68 + 16 * dt + 4 * fq); if (g == 0) *op = o[dt]; else *op = *op + o[dt]; }
            if (fq == 0) { if (g == 0) Lacc[tl] = lsum; else Lacc[tl] += lsum; }
        }
        __syncthreads();
    }
    bf16_t* O = (bf16_t*)(F.ws + WS_O);
#pragma unroll
    for (int i = 0; i < 4; ++i) { const int pc = F.tid + 512 * i, tl = pc >> 3, ch = pc & 7;
        const float inv = 1.0f / Lacc[tl];
        const f32x4 a = *(const LAS f32x4*)(Oacc + tl * 68 + ch * 8) * inv, b = *(const LAS f32x4*)(Oacc + tl * 68 + ch * 8 + 4) * inv;
        *(u32x4*)(O + (size_t)(bl * SEQ + blk * 256 + tl) * OW + OC_DA + j * 64 + ch * 8) = pg8::pack8(a, b); }
    __syncthreads();
}
__device__ __forceinline__ void ret_C(const Frame& F, const LayerP& P, int unit) {
    const int bl = unit >> 6, h = (unit >> 4) & 3, n = unit & 15, row0 = bl * SEQ + n * 128;
    const bf16_t* Z = (const bf16_t*)(F.ws + WS_Z);
    LAS unsigned char* Kimg = F.lds; LAS unsigned char* Vimg = F.lds + 128 * RS128; LAS unsigned char* Simg = F.lds + 2 * 128 * RS128;
    load_tile<128>(F, Z + (size_t)row0 * NZ + ZC_RK + h * 128, NZ, Kimg, RS128);
    load_tile<128>(F, Z + (size_t)row0 * NZ + ZC_RV + h * 128, NZ, Vimg, RS128);
    load_tile<128>(F, (const bf16_t*)(F.ws + WS_RU) + (size_t)unit * 16384, 128, Simg, RS128);
    const int w = F.wave, lane = F.lane, fr = lane & 15, fq = lane >> 4;
    const float lg = ret_log2gamma(h);
    const int qi = 16 * w + fr;
    const bf16_t* qp = Z + (size_t)(row0 + qi) * NZ + ZC_RQ + h * 128 + 8 * fq;
    bf16x8 qf[4];
#pragma unroll
    for (int ks = 0; ks < 4; ++ks) qf[ks] = *(const bf16x8*)(qp + 32 * ks);
    __syncthreads();
    f32x4 intra[8];
#pragma unroll
    for (int dvt = 0; dvt < 8; ++dvt) intra[dvt] = (f32x4){0.f, 0.f, 0.f, 0.f};
    for (int kp = 0; kp <= (w >> 1); ++kp) {
        u32x2 pp[2];
#pragma unroll
        for (int t = 0; t < 2; ++t) {
            const int kt = 2 * kp + t;
            f32x4 s = {0.f, 0.f, 0.f, 0.f};
            if (kt <= w) {
#pragma unroll
                for (int ks = 0; ks < 4; ++ks) s = mfma16(rowfrag(Kimg, RS128, 16 * kt + fr, (32 * ks + 8 * fq) * 2), qf[ks], s);
            }
            float p[4];
#pragma unroll
            for (int e = 0; e < 4; ++e) { const int kj = 16 * kt + 4 * fq + e; p[e] = (kj <= qi) ? s[e] * fast_exp2(lg * (float)(qi - kj)) : 0.f; }
            pp[t].x = cvt_pk_bf16(p[0], p[1]); pp[t].y = cvt_pk_bf16(p[2], p[3]);
        }
        const bf16x8 pb = as_bf16x8((u32x4){pp[0].x, pp[0].y, pp[1].x, pp[1].y});
#pragma unroll
        for (int dvt = 0; dvt < 8; ++dvt) intra[dvt] = mfma16(TR_PERM(Vimg, RS128, 32 * kp, 16 * dvt, lane), pb, intra[dvt]);
    }
    const float qdec = fast_exp2(lg * (float)(qi + 1));
    const bf16_t* gp = Z + (size_t)(row0 + qi) * NZ + ZC_RG + h * 128;
    f32x4 nwv[8]; u32x2 gvv[8];
#pragma unroll
    for (int dvt = 0; dvt < 8; ++dvt) { nwv[dvt] = *(const f32x4*)(P.ret_norm_w + h * 128 + 16 * dvt + 4 * fq); gvv[dvt] = *(const u32x2*)(gp + 16 * dvt + 4 * fq); }
    float ss = 0.f;
#pragma unroll
    for (int dvt = 0; dvt < 8; ++dvt) { f32x4 a = {0.f, 0.f, 0.f, 0.f};
#pragma unroll
        for (int ks = 0; ks < 4; ++ks) a = mfma16(rowfrag(Simg, RS128, 16 * dvt + fr, (32 * ks + 8 * fq) * 2), qf[ks], a);
        intra[dvt] = intra[dvt] + a * qdec; const f32x4 x = intra[dvt]; ss += (x[0] * x[0] + x[1] * x[1]) + (x[2] * x[2] + x[3] * x[3]); }
    ss += __shfl_xor(ss, 16); ss += __shfl_xor(ss, 32);
    const float hr = __builtin_amdgcn_rsqf(ss * (1.0f / 128.0f) + EPS);
    bf16_t* O = (bf16_t*)(F.ws + WS_O) + (size_t)(row0 + qi) * OW + OC_RET + h * 128;
#pragma unroll
    for (int dvt = 0; dvt < 8; ++dvt) { const int dv = 16 * dvt + 4 * fq;
        const f32x4 nw = nwv[dvt]; const u32x2 gv = gvv[dvt];
        const f32x4 x = intra[dvt] * hr * nw;
        u32x2 o; o.x = cvt_pk_bf16(x[0] * siluf_(bf_lo(gv.x)), x[1] * siluf_(bf_hi(gv.x))); o.y = cvt_pk_bf16(x[2] * siluf_(bf_lo(gv.y)), x[3] * siluf_(bf_hi(gv.y)));
        *(u32x2*)(O + dv) = o; }
    __syncthreads();
}
__device__ __forceinline__ void ml_C(const Frame& F, const LayerP& P, int unit) {
    const int bl = unit >> 6, h = (unit >> 4) & 3, n = unit & 15, row0 = bl * SEQ + n * 128;
    const bf16_t* Z = (const bf16_t*)(F.ws + WS_Z);
    LAS unsigned char* Kimg = F.lds; LAS unsigned char* Vimg = F.lds + 128 * RS64; LAS unsigned char* Cimg = Vimg + 128 * RS128;
    LAS float* ig = (LAS float*)(Cimg + 128 * RS64); LAS float* bc = ig + 128; LAS float* t0 = bc + 128;
    LAS float* clog = t0 + 128; LAS float* wi = clog + 128; LAS float* em = wi + 128; LAS float* nv = em + 128;
    const int kch = F.tid & 7;
    const Conv8W kw8 = conv8_weights(P.conv_w + 256 + h * 64 + kch * 8);
    Conv8Rows kr[2]; u32x4 vraw[4]; u32x4 craw[2];
#pragma unroll
    for (int i = 0; i < 2; ++i) kr[i] = conv8_rows(Z, row0 + ((F.tid + 512 * i) >> 3), ZC_MK + h * 64 + kch * 8);
#pragma unroll
    for (int i = 0; i < 4; ++i) { const int pc = F.tid + 512 * i, r = pc >> 4, ch = pc & 15; vraw[i] = *(const u32x4*)(Z + (size_t)(row0 + r) * NZ + ZC_MV + h * 128 + ch * 8); }
    { const bf16_t* cg = (const bf16_t*)(F.ws + WS_MU) + (size_t)unit * 8192;
#pragma unroll
        for (int i = 0; i < 2; ++i) { const int pc = F.tid + 512 * i, r = pc >> 3, ch = pc & 7; craw[i] = *(const u32x4*)(cg + (size_t)r * 64 + ch * 8); } }
    const float nvraw = (F.tid >= 128 && F.tid < 192) ? ((const float*)(F.ws + WS_MNV))[(size_t)unit * 64 + F.tid - 128] : 0.f;
    ml_gates(F, P, row0, h, ig, bc, t0);
    const float mm = ((const float*)(F.ws + WS_MSC))[(size_t)unit * 4 + 2];
    float pmv = -3.0e38f;
    if (F.tid < 128) { pmv = ig[F.tid] - bc[F.tid];
#pragma unroll
        for (int o = 1; o < 64; o <<= 1) { const float t = __shfl_up(pmv, o); if (F.lane >= o) pmv = fmaxf(pmv, t); }
        if (F.tid == 63) nv[0] = pmv; }
    __syncthreads();
    if (F.tid < 128) { const int i = F.tid; const float pm = (i >= 64) ? fmaxf(pmv, nv[0]) : pmv;
        const float mi = bc[i] + fmaxf(mm, pm);
        clog[i] = (ig[i] - bc[i]) * LOG2E; wi[i] = __expf(bc[i] + mm - mi); em[i] = __expf(-mi);
        t0[i] = (bc[i] - mi) * LOG2E; }
    __syncthreads();
    const int w = F.wave, lane = F.lane, fr = lane & 15, fq = lane >> 4, qi = 16 * w + fr;
    if (F.tid >= 128 && F.tid < 192) nv[F.tid - 128] = nvraw;
#pragma unroll
    for (int i = 0; i < 2; ++i) { const int pc = F.tid + 512 * i, r = pc >> 3;
        *(LAS u32x4*)(Kimg + r * RS64 + kch * 16) = conv8_finish(kr[i], kw8, row0 + r, 0.125f); }
#pragma unroll
    for (int i = 0; i < 4; ++i) { const int pc = F.tid + 512 * i, r = pc >> 4, ch = pc & 15; *(LAS u32x4*)(Vimg + r * RS128 + ch * 16) = vraw[i]; }
#pragma unroll
    for (int i = 0; i < 2; ++i) { const int pc = F.tid + 512 * i, r = pc >> 3, ch = pc & 7; *(LAS u32x4*)(Cimg + r * RS64 + ch * 16) = craw[i]; }
    Conv8Rows qr[2]; Conv8W qw8[2];
#pragma unroll
    for (int ks = 0; ks < 2; ++ks) { qr[ks] = conv8_rows(Z, row0 + qi, ZC_MQ + h * 64 + 32 * ks + 8 * fq); qw8[ks] = conv8_weights(P.conv_w + h * 64 + 32 * ks + 8 * fq); }
    bf16x8 qf[2];
#pragma unroll
    for (int ks = 0; ks < 2; ++ks) qf[ks] = as_bf16x8(conv8_finish(qr[ks], qw8[ks], row0 + qi, 1.0f));
    __syncthreads();
    const LAS float* rlog = t0;
    float qn = 0.f;
#pragma unroll
    for (int ks = 0; ks < 2; ++ks)
#pragma unroll
        for (int e = 0; e < 8; ++e) qn += bf2f((bf16_t)qf[ks][e]) * nv[32 * ks + 8 * fq + e];
    qn += __shfl_xor(qn, 16); qn += __shfl_xor(qn, 32);
    f32x4 intra[8];
#pragma unroll
    for (int dvt = 0; dvt < 8; ++dvt) intra[dvt] = (f32x4){0.f, 0.f, 0.f, 0.f};
    const float rl = rlog[qi];
    float rsum = 0.f;
    for (int kp = 0; kp <= (w >> 1); ++kp) {
        u32x2 pp[2];
#pragma unroll
        for (int t = 0; t < 2; ++t) {
            const int kt = 2 * kp + t;
            f32x4 s = {0.f, 0.f, 0.f, 0.f};
            if (kt <= w) {
#pragma unroll
                for (int ks = 0; ks < 2; ++ks) s = mfma16(rowfrag(Kimg, RS64, 16 * kt + fr, (32 * ks + 8 * fq) * 2), qf[ks], s);
            }
            float p[4];
#pragma unroll
            for (int e = 0; e < 4; ++e) { const int kj = 16 * kt + 4 * fq + e; p[e] = (kj <= qi) ? s[e] * fast_exp2(rl + clog[kj & 127]) : 0.f; rsum += p[e]; }
            pp[t].x = cvt_pk_bf16(p[0], p[1]); pp[t].y = cvt_pk_bf16(p[2], p[3]);
        }
        const bf16x8 pb = as_bf16x8((u32x4){pp[0].x, pp[0].y, pp[1].x, pp[1].y});
#pragma unroll
        for (int dvt = 0; dvt < 8; ++dvt) intra[dvt] = mfma16(TR_PERM(Vimg, RS128, 32 * kp, 16 * dvt, lane), pb, intra[dvt]);
    }
    rsum += __shfl_xor(rsum, 16); rsum += __shfl_xor(rsum, 32);
    const bf16_t* gp = Z + (size_t)(row0 + qi) * NZ + ZC_MO + h * 128;
    f32x4 nwv[8]; u32x2 gvv[8];
#pragma unroll
    for (int dvt = 0; dvt < 8; ++dvt) { nwv[dvt] = *(const f32x4*)(P.ml_norm_w + h * 128 + 16 * dvt + 4 * fq); gvv[dvt] = *(const u32x2*)(gp + 16 * dvt + 4 * fq); }
    const float wq = wi[qi], den = rsum + wq * qn, dinv = 1.0f / fmaxf(fabsf(den), em[qi]);
    float ss = 0.f;
#pragma unroll
    for (int dvt = 0; dvt < 8; ++dvt) { f32x4 a = {0.f, 0.f, 0.f, 0.f};
#pragma unroll
        for (int ks = 0; ks < 2; ++ks) a = mfma16(rowfrag(Cimg, RS64, 16 * dvt + fr, (32 * ks + 8 * fq) * 2), qf[ks], a);
        intra[dvt] = (intra[dvt] + a * wq) * dinv; const f32x4 x = intra[dvt]; ss += (x[0] * x[0] + x[1] * x[1]) + (x[2] * x[2] + x[3] * x[3]); }
    ss += __shfl_xor(ss, 16); ss += __shfl_xor(ss, 32);
    const float hr = __builtin_amdgcn_rsqf(ss * (1.0f / 128.0f) + EPS);
    bf16_t* O = (bf16_t*)(F.ws + WS_O) + (size_t)(row0 + qi) * OW + OC_ML + h * 128;
#pragma unroll
    for (int dvt = 0; dvt < 8; ++dvt) { const int dv = 16 * dvt + 4 * fq;
        const f32x4 nw = nwv[dvt]; const u32x2 gv = gvv[dvt];
        const f32x4 x = intra[dvt] * hr * nw;
        u32x2 o; o.x = cvt_pk_bf16(x[0] * sigmoidf_(bf_lo(gv.x)), x[1] * sigmoidf_(bf_hi(gv.x))); o.y = cvt_pk_bf16(x[2] * sigmoidf_(bf_lo(gv.y)), x[3] * sigmoidf_(bf_hi(gv.y)));
        *(u32x2*)(O + dv) = o; }
    __syncthreads();
}
struct MoeP { const float *w_router, *b_router, *w_gate, *w_up, *w_down, *norm2_w; };
__device__ __forceinline__ void moe_R1(const Frame& F, const MoeP& M, const bf16_t* xres, const float* ssqp) {
    LAS float* WrT = (LAS float*)F.lds;
    LAS int* pickE = (LAS int*)(F.lds + 32768);
    LAS int* lrank = pickE + 256;
    for (int i = F.tid; i < 8 * D; i += 512) { const int e = i >> 10, k = i & 1023; WrT[i] = M.norm2_w[k] * M.w_router[k * 8 + e]; }
    __syncthreads();
    unsigned* toke = (unsigned*)(F.ws + WS_TOKE); float* tokp = (float*)(F.ws + WS_TOKP); float* tokr = (float*)(F.ws + WS_TOKR);
    int* toks = (int*)(F.ws + WS_TOKS); int* elist = (int*)(F.ws + WS_ELIST); unsigned* cnt = (unsigned*)(F.ws + WS_CTL) + CW_CNT;
    const int lane = F.lane;
    for (int tb = blockIdx.x; tb < T / 128; tb += F.G) {
        u32x2 rn[4]; f32x4 sn[4];
        { const int t0 = tb * 128 + F.wave * 16; const u32x2* xr = (const u32x2*)(xres + (size_t)t0 * (2 * D)) + lane; const f32x4* sp = (const f32x4*)(ssqp + (size_t)t0 * 16);
#pragma unroll
            for (int j = 0; j < 4; ++j) { rn[j] = xr[64 * j]; sn[j] = sp[j]; } }
        for (int it = 0; it < 16; ++it) {
            const int tl = F.wave * 16 + it, t = tb * 128 + tl;
            f32x4 v[4];
#pragma unroll
            for (int j = 0; j < 4; ++j) { const u32x2 r = rn[j]; v[j] = (f32x4){bf_lo(r.x), bf_hi(r.x), bf_lo(r.y), bf_hi(r.y)}; }
            const f32x4 ssum = (sn[0] + sn[1]) + (sn[2] + sn[3]);
            const float rstd = __builtin_amdgcn_rsqf(((ssum[0] + ssum[1]) + (ssum[2] + ssum[3])) * (1.0f / D) + EPS);
            if (it < 15) { const u32x2* xr = (const u32x2*)(xres + (size_t)(t + 1) * (2 * D)) + lane; const f32x4* sp = (const f32x4*)(ssqp + (size_t)(t + 1) * 16);
#pragma unroll
                for (int j = 0; j < 4; ++j) { rn[j] = xr[64 * j]; sn[j] = sp[j]; } }
            float lg[8];
#pragma unroll
            for (int e = 0; e < 8; ++e) { float a = 0.f;
#pragma unroll
                for (int j = 0; j < 4; ++j) { const f32x4 wv = *(const LAS f32x4*)(WrT + e * D + 256 * j + 4 * lane); a += (v[j][0] * wv[0] + v[j][1] * wv[1]) + (v[j][2] * wv[2] + v[j][3] * wv[3]); }
                lg[e] = wave_sum(a) * rstd + M.b_router[e]; }
            int e1 = 0; float v1 = lg[0];
#pragma unroll
            for (int e = 1; e < 8; ++e) if (lg[e] > v1) { v1 = lg[e]; e1 = e; }
            int e2 = -1; float v2 = -3.0e38f;
#pragma unroll
            for (int e = 0; e < 8; ++e) if (e != e1 && lg[e] > v2) { v2 = lg[e]; e2 = e; }
            if (lane == 0) { toke[t] = (unsigned)e1 | ((unsigned)e2 << 8); tokp[t] = 1.0f / (1.0f + __expf(v2 - v1)); tokr[t] = rstd; pickE[tl * 2] = e1; pickE[tl * 2 + 1] = e2; }
        }
        __syncthreads();
        if (F.wave == 0) {
            int pe[4], lr[4], mine = 0;
#pragma unroll
            for (int r = 0; r < 4; ++r) { pe[r] = pickE[r * 64 + lane]; lr[r] = 0; }
#pragma unroll
            for (int e = 0; e < 8; ++e) {
                int base = 0;
#pragma unroll
                for (int r = 0; r < 4; ++r) { const bool m = pe[r] == e; const unsigned long long bal = __ballot(m);
                    if (m) lr[r] = base + __popcll(bal & ((1ull << lane) - 1ull)); base += __popcll(bal); }
                if (lane == e) mine = base;
            }
            int gbv = 0; if (lane < 8 && mine > 0) gbv = (int)atomicAdd(cnt + 64 * lane, (unsigned)mine);
#pragma unroll
            for (int r = 0; r < 4; ++r) { const int ent = r * 64 + lane, e = pe[r]; const int rank = __shfl(gbv, e) + lr[r]; toks[(size_t)tb * 256 + ent] = rank; elist[(size_t)e * T + rank] = tb * 128 + (ent >> 1); }
        }
        __syncthreads();
    }
}
__device__ __forceinline__ void moe_R2(const Frame& F, const bf16_t* xres) {
    LAS int* ts = (LAS int*)F.lds; LAS int* cn = ts + 16;
    const unsigned* cnt = (const unsigned*)(F.ws + WS_CTL) + CW_CNT;
    if (F.tid < 8) cn[F.tid] = (int)__hip_atomic_load(cnt + 64 * F.tid, __ATOMIC_RELAXED, __HIP_MEMORY_SCOPE_AGENT);
    __syncthreads();
    if (F.tid == 0) { int acc = 0; for (int e = 0; e < 8; ++e) { const int c = cn[e]; ts[e] = acc; acc += (c + 255) >> 8; } ts[8] = acc;
        if (blockIdx.x == 0) { int* g = (int*)(F.ws + WS_TS); for (int e = 0; e < 9; ++e) g[e] = ts[e]; } }
    __syncthreads();
    const int nslot = ts[8] * 256, lane = F.lane;
    const bf16_t* xb = xres; unsigned char* xg = F.ws + WS_XG;
    const int* elist = (const int*)(F.ws + WS_ELIST); const float* tokr = (const float*)(F.ws + WS_TOKR);
    for (int slot0 = F.gw; slot0 < nslot; slot0 += 4 * F.NGW) {
        int tk[4]; bool ok[4];
#pragma unroll
        for (int q = 0; q < 4; ++q) { const int slot = slot0 + q * F.NGW; ok[q] = false; tk[q] = 0;
            if (slot < nslot) { const int mt = slot >> 8; int e = 0;
#pragma unroll
                for (int k = 1; k < 8; ++k) e += (mt >= ts[k]);
                const int r = slot - ts[e] * 256;
                if (r < cn[e]) { ok[q] = true; tk[q] = elist[(size_t)e * T + r]; } } }
        u32x4 a[4], b[4]; float rs[4];
#pragma unroll
        for (int q = 0; q < 4; ++q) { a[q] = (u32x4){0u, 0u, 0u, 0u}; b[q] = a[q]; rs[q] = 0.f;
            if (ok[q]) { const u32x4* src = (const u32x4*)(xb + (size_t)tk[q] * (2 * D)); a[q] = __builtin_nontemporal_load(src + 2 * lane); b[q] = __builtin_nontemporal_load(src + 2 * lane + 1); rs[q] = tokr[tk[q]]; } }
#pragma unroll
        for (int q = 0; q < 4; ++q) { const int slot = slot0 + q * F.NGW;
            if (slot < nslot) {
                u32x4 w8; const float sc = ACT8_SCALE * rs[q];
                w8.x = cvt_pk4_fp8(bf_lo(a[q].x) * sc, bf_hi(a[q].x) * sc, bf_lo(a[q].y) * sc, bf_hi(a[q].y) * sc);
                w8.y = cvt_pk4_fp8(bf_lo(a[q].z) * sc, bf_hi(a[q].z) * sc, bf_lo(a[q].w) * sc, bf_hi(a[q].w) * sc);
                w8.z = cvt_pk4_fp8(bf_lo(b[q].x) * sc, bf_hi(b[q].x) * sc, bf_lo(b[q].y) * sc, bf_hi(b[q].y) * sc);
                w8.w = cvt_pk4_fp8(bf_lo(b[q].z) * sc, bf_hi(b[q].z) * sc, bf_lo(b[q].w) * sc, bf_hi(b[q].w) * sc);
                ((u32x4*)(xg + (size_t)slot * D))[lane] = w8; } }
    }
}
__device__ __forceinline__ void moe_combine(const Frame& F, float* out, const bf16_t* xres) {
    const unsigned* toke = (const unsigned*)(F.ws + WS_TOKE); const float* tokp = (const float*)(F.ws + WS_TOKP); const int* toks = (const int*)(F.ws + WS_TOKS);
    const int* ts = (const int*)(F.ws + WS_TS); const bf16_t* yd = (const bf16_t*)(F.ws + WS_YD);
    for (int t0 = F.gw; t0 < T; t0 += 2 * F.NGW) {
        unsigned ee[2]; float p1[2]; int r1[2], r2[2];
#pragma unroll
        for (int q = 0; q < 2; ++q) { const int t = (t0 + q * F.NGW < T) ? t0 + q * F.NGW : t0; ee[q] = toke[t]; p1[q] = tokp[t]; r1[q] = toks[2 * (size_t)t]; r2[q] = toks[2 * (size_t)t + 1]; }
        size_t s1[2], s2[2];
#pragma unroll
        for (int q = 0; q < 2; ++q) { const int e1 = ee[q] & 255, e2 = (ee[q] >> 8) & 255; s1[q] = (size_t)ts[e1] * 256 + r1[q]; s2[q] = (size_t)ts[e2] * 256 + r2[q]; }
        u32x2 x[2][4]; u32x2 ya[2][4], yb[2][4];
#pragma unroll
        for (int q = 0; q < 2; ++q) { const int t = (t0 + q * F.NGW < T) ? t0 + q * F.NGW : t0;
            const u32x2* o = (const u32x2*)(xres + (size_t)t * (2 * D)) + F.lane; const u32x2* y1 = (const u32x2*)(yd + s1[q] * D) + F.lane; const u32x2* y2 = (const u32x2*)(yd + s2[q] * D) + F.lane;
#pragma unroll
            for (int j = 0; j < 4; ++j) { x[q][j] = __builtin_nontemporal_load(o + 64 * j); ya[q][j] = __builtin_nontemporal_load(y1 + 64 * j); yb[q][j] = __builtin_nontemporal_load(y2 + 64 * j); } }
#pragma unroll
        for (int q = 0; q < 2; ++q) { const int t = t0 + q * F.NGW; const float pa = p1[q], pb = 1.0f - pa;
            if (t >= T) break;
            f32x4* o = (f32x4*)(out + (size_t)t * D) + F.lane;
#pragma unroll
            for (int j = 0; j < 4; ++j) { const u32x2 xr = x[q][j]; f32x4 v = {bf_lo(xr.x), bf_hi(xr.x), bf_lo(xr.y), bf_hi(xr.y)}; const u32x2 a = ya[q][j], b = yb[q][j];
                v[0] += pa * bf_lo(a.x) + pb * bf_lo(b.x); v[1] += pa * bf_hi(a.x) + pb * bf_hi(b.x); v[2] += pa * bf_lo(a.y) + pb * bf_lo(b.y); v[3] += pa * bf_hi(a.y) + pb * bf_hi(b.y);
                o[64 * j] = v; } }
    }
}

#define CAS __attribute__((address_space(4)))
struct Args { const float* in[23]; float* out; unsigned char* ws; int ph_lo, ph_hi, li, pad; };
template <class T> __device__ __forceinline__ T* asg(T* p) { return (T*)(GAS T*)p; }
__device__ __forceinline__ const CAS Args* kargs() { unsigned zo = 0u; asm volatile("" : "+s"(zo)); return (const CAS Args*)((const CAS char*)__builtin_amdgcn_kernarg_segment_ptr() + zo); }
__device__ __forceinline__ int wg_index() { int c = (int)blockIdx.x; asm volatile("" : "+s"(c)); return c; }
__device__ __forceinline__ bool refresh(Frame& F) { F.ws = asg(kargs()->ws); int t = threadIdx.x; asm volatile("" : "+v"(t)); F.tid = t; F.lane = t & 63; F.wave = __builtin_amdgcn_readfirstlane(t >> 6); F.gw = blockIdx.x * 8 + F.wave; return true; }
#ifndef EN_MASK
#define EN_MASK 0xFFFF
#endif
#define EN(k) ((EN_MASK >> (k)) & 1)
#ifndef REP_G1
#define REP_G1 1
#endif
#ifndef REP_MIX
#define REP_MIX 1
#endif
#ifndef REP_A
#define REP_A REP_MIX
#endif
#ifndef REP_B
#define REP_B REP_MIX
#endif
#ifndef REP_C
#define REP_C REP_MIX
#endif
#ifndef REP_FFNUP
#define REP_FFNUP 1
#endif
#ifndef REP_MUP
#define REP_MUP 1
#endif
#ifndef REP_G2
#define REP_G2 1
#endif
#ifndef REP_CONV
#define REP_CONV 1
#endif
#ifndef REP_MOE
#define REP_MOE 1
#endif
#define RUN() (lo <= ph && ph < hi && refresh(F))
#define SEAM() do { if (lo <= ph && ph + 1 < hi) { const CAS Args* ka_ = kargs(); XcdBarrier bar_; bar_.bar = (unsigned*)(asg(ka_->ws) + WS_CTL) + CW_BAR + ka_->li * XCD_BAR_WORDS; bar_.x = xb_xcc_id(); bar_.st = (volatile LAS unsigned*)(F.lds + MISC_OFF) + 8; xcd_barrier(bar_); } ++ph; } while (0)
#define SEAM_X() do { if (lo <= ph && ph + 1 < hi) { volatile LAS unsigned* st_ = (volatile LAS unsigned*)(F.lds + MISC_OFF) + 8; const CAS Args* ka_ = kargs(); unsigned* bw_ = (unsigned*)(asg(ka_->ws) + WS_CTL) + CW_BAR + ka_->li * XCD_BAR_WORDS; \
        if (st_[2]) xcd_local_barrier(bw_, xb_xcc_id(), st_[0]); else { XcdBarrier bar_; bar_.bar = bw_; bar_.x = xb_xcc_id(); bar_.st = st_; xcd_barrier(bar_); } } ++ph; } while (0)
#define x_in (asg(kargs()->in[0]))
#define out (asg(kargs()->out))
#define ssq ((float*)(F.ws + WS_SSQ))
#define XB ((bf16_t*)(F.ws + WS_XB))
#define lo (kargs()->ph_lo)
#define hi (kargs()->ph_hi)
#define MKP() LayerP P; P.ret_norm_w = asg(kargs()->in[3]) + layer * 512; P.da_qw = asg(kargs()->in[4]) + layer * 64; P.da_kw = asg(kargs()->in[5]) + layer * 64; P.conv_w = asg(kargs()->in[6]) + layer * 2048; \
        P.i_bias = asg(kargs()->in[7]) + layer * 4; P.f_bias = asg(kargs()->in[8]) + layer * 4; P.ml_norm_w = asg(kargs()->in[9]) + layer * 512
__device__ __forceinline__ void group_phases(Frame& F, int& ph, const int layer, const int g) {
    const volatile LAS unsigned* stx = (const volatile LAS unsigned*)(F.lds + MISC_OFF) + 8;
    const int c = __builtin_amdgcn_readfirstlane(stx[2] ? (int)(stx[4] * 8u + xb_xcc_id()) : (int)blockIdx.x);
            if (EN(1) && RUN()) {
                LAS float* rtab = (LAS float*)(F.lds + MISC_OFF + 1024);
                {
                    pg8::Gemm gm{XB + (size_t)g * TG * D, (const bf16_t*)(F.ws + WS_WIN) + (size_t)layer * NZ * D, D * 2, D * 2, D / 64, 0};
                    pg8::ListOrder S; S.init(TG, 16 * 256, F.G, c); S.tl_lo = TL16_LO; S.tl_hi = TL16_HI;
                    pg8::EpiG1 E{(bf16_t*)(F.ws + WS_Z), (float*)(F.ws + WS_GATES), rtab, (const float*)(F.ws + WS_ROPE), asg(kargs()->in[4]) + layer * 64, asg(kargs()->in[5]) + layer * 64, 1};
                    pg8::fill_rstd_table(S, ssq + (size_t)g * TG * 16, rtab, 2);
                    for (int rep = 0; rep < REP_G1; ++rep) pg8::gemm_phase<pg8::EpiG1, pg8::ListOrder, true, true>(F.lds, gm, S, E);
                }
                {
                    pg8::Gemm gm{F.ws + WS_XB8G, F.ws + WS_WIN + (size_t)layer * NZ * D * 2, D, 2 * D, D / 128, 0};
                    pg8::ListOrder S; S.init(TG, 20 * 256, F.G, c); S.tl_lo = TL20_LO; S.tl_hi = TL20_HI;
                    pg8::EpiGate8 E{(bf16_t*)(F.ws + WS_Z), rtab + 8 * 256, 1};
                    pg8::fill_rstd_table(S, ssq + (size_t)g * TG * 16, rtab + 8 * 256, 2);
                    for (int rep = 0; rep < REP_G1; ++rep) pg8::gemm_phase<pg8::EpiGate8, pg8::ListOrder, true, false, true>(F.lds, gm, S, E);
                }
            }
            SEAM_X();
            if (EN(2) && RUN()) {
                MKP();
                for (int rep = 0; rep < REP_A; ++rep) for (int u = c; u < 1792; u += F.G) { const int bl = u & 7, v = u >> 3;
                    if (v < 64) ret_A(F, bl * 64 + v); else if (v < 128) ml_A(F, P, bl * 64 + v - 64); else vt_A(F, bl * 96 + v - 128); }
            }
            SEAM_X();
            if (EN(3) && RUN()) {
                MKP();
                scan_B(F, c);
                for (int rep = 0; rep < REP_B; ++rep) for (int u = c; u < 256; u += F.G) attn_B(F, P, (u & 7) * 32 + (u >> 3));
            }
            SEAM_X();
            if (EN(4) && RUN()) {
                MKP();
                for (int rep = 0; rep < REP_C; ++rep) for (int u = c; u < 1024; u += F.G) { const int bl = u & 7, v = u >> 3; if (v < 64) ret_C(F, P, bl * 64 + v); else ml_C(F, P, bl * 64 + v - 64); }
            }
            SEAM_X();
            if (EN(5) && RUN()) {
                for (int jr = 0; jr < 3 * REP_G2; ++jr) { const int j = jr % 3;
                    const int kofs = j == 0 ? 0 : (j == 1 ? 512 : 768), kk = j == 1 ? 256 : 512;
                    pg8::Gemm gm{(const bf16_t*)(F.ws + WS_O) + kofs, (const bf16_t*)(F.ws + WS_WBR) + (size_t)layer * D * OW + kofs, OW * 2, OW * 2, kk / 64, 0};
                    pg8::StaticOrder S; S.init(TG, D, F.G, c);
                    pg8::EpiBranch E{(bf16_t*)(F.ws + WS_Y), (const bf16_t*)(F.ws + WS_Z) + ZC_SG + 1024 * j, j == 0};
                    pg8::gemm_phase<pg8::EpiBranch, pg8::StaticOrder, true, true>(F.lds, gm, S, E);
                }
            }
            SEAM_X();
            if (EN(6) && RUN()) {
                pg8::Gemm gm{(const bf16_t*)(F.ws + WS_Y), (const bf16_t*)(F.ws + WS_WOUT) + (size_t)layer * D * D, D * 2, D * 2, D / 64, 0};
                pg8::StaticOrder S; S.init(TG, D, F.G, c);
                const size_t ro = (size_t)g * TG * D;
                unsigned char* xb8 = nullptr;
                if (g == 0) {
                    const u32x4* src = (const u32x4*)(XB + (size_t)TG * D); u32x2* dst = (u32x2*)(F.ws + WS_XB8G);
                    const size_t per_b = (size_t)SEQ * D / 8;
                    for (size_t j = (size_t)(c >> 3) * 512 + F.tid; j < per_b; j += (size_t)(F.G >> 3) * 512) { const size_t i = (size_t)(c & 7) * per_b + j; const u32x4 v = src[i]; u32x2 w8;
                        w8.x = cvt_pk4_fp8(bf_lo(v.x) * ACT8_SCALE, bf_hi(v.x) * ACT8_SCALE, bf_lo(v.y) * ACT8_SCALE, bf_hi(v.y) * ACT8_SCALE);
                        w8.y = cvt_pk4_fp8(bf_lo(v.z) * ACT8_SCALE, bf_hi(v.z) * ACT8_SCALE, bf_lo(v.w) * ACT8_SCALE, bf_hi(v.w) * ACT8_SCALE); dst[i] = w8; }
                }
                pg8::EpiResid E{XB + ro, nullptr, layer == 0 ? XB + ro : (bf16_t*)out + 2 * ro, ssq + (size_t)g * TG * 16, xb8, layer == 0 ? D : 2 * D};
                pg8::gemm_phase<pg8::EpiResid, pg8::StaticOrder, true, true>(F.lds, gm, S, E);
            }
            if (g + 1 < NGRP) SEAM_X(); else SEAM();
}
__global__ void __launch_bounds__(512, 2) fwd(Args args) {
    extern __shared__ __attribute__((aligned(16))) unsigned char lds_raw[];
    Frame F;
    F.lds = (LAS unsigned char*)lds_raw; F.ws = asg(kargs()->ws);
    F.tid = threadIdx.x; F.lane = F.tid & 63; F.wave = __builtin_amdgcn_readfirstlane(F.tid >> 6);
    F.G = gridDim.x; F.gw = blockIdx.x * 8 + F.wave; F.NGW = F.G * 8;
    volatile LAS unsigned* MISC = (volatile LAS unsigned*)(F.lds + MISC_OFF);
    if (F.tid < 64) MISC[F.tid] = 0u;
    __syncthreads();
    (void)xcd_barrier_post((unsigned*)(F.ws + WS_CTL) + CW_BAR + kargs()->li * XCD_BAR_WORDS, MISC + 8);
    int ph = 0;

    if (EN(0) && RUN()) {
        int woff = 0;
        for (int l = 0; l < 2 * REP_CONV; ++l) {
            convert_w<false>(F, woff, PIN, D, 16 * 256, (bf16_t*)(F.ws + WS_WIN) + (size_t)(l & 1) * NZ * D, D, 0, asg(kargs()->in[1]) + (l & 1) * D, MapWinSel{asg(kargs()->in[2]) + (size_t)(l & 1) * D * PIN, TL16_LO, TL16_HI});
            convert_w<true>(F, woff, PIN, D, 20 * 256, F.ws + WS_WIN + (size_t)(l & 1) * NZ * D * 2, 2 * D, 0, asg(kargs()->in[1]) + (l & 1) * D, MapWinSel{asg(kargs()->in[2]) + (size_t)(l & 1) * D * PIN, TL20_LO, TL20_HI});
            convert_w<false>(F, woff, D, 512, D, (bf16_t*)(F.ws + WS_WBR) + (size_t)(l & 1) * D * OW, OW, 0, nullptr, MapIdent{asg(kargs()->in[10]) + (size_t)(l & 1) * 512 * D});
            convert_w<false>(F, woff, D, 256, D, (bf16_t*)(F.ws + WS_WBR) + (size_t)(l & 1) * D * OW, OW, 512, nullptr, MapIdent{asg(kargs()->in[11]) + (size_t)(l & 1) * 256 * D});
            convert_w<false>(F, woff, D, 512, D, (bf16_t*)(F.ws + WS_WBR) + (size_t)(l & 1) * D * OW, OW, 768, nullptr, MapIdent{asg(kargs()->in[12]) + (size_t)(l & 1) * 512 * D});
            convert_w<false>(F, woff, D, D, D, (bf16_t*)(F.ws + WS_WOUT) + (size_t)(l & 1) * D * D, D, 0, nullptr, MapIdent{asg(kargs()->in[13]) + (size_t)(l & 1) * D * D});
        }
        convert_w<false>(F, woff, FF, D, 2 * FF, F.ws + WS_WUP, D, 0, asg(kargs()->in[14]), MapGateUp{asg(kargs()->in[15]), asg(kargs()->in[16])});
        convert_w<false>(F, woff, D, FF, D, F.ws + WS_WDN, FF, 0, nullptr, MapIdent{asg(kargs()->in[17])});
        p0_rows(F, x_in);
        p0_rope(F);
    }
    SEAM();

    for (int layer = 0; layer < 2; ++layer) {
        for (int g = 0; g < NGRP; ++g) group_phases(F, ph, layer, g);
        if (layer == 0) {
            if (EN(7) && RUN()) {
                pg8::Gemm gm{XB, F.ws + WS_WUP, D * 2, D * 2, D / 64, 0};
                pg8::StaticOrder S; S.init(T, 2 * FF, F.G, wg_index());
                LAS float* rtab = (LAS float*)(F.lds + MISC_OFF + 1024);
                pg8::EpiSwiglu<false> E{F.ws + WS_A1, FF, nullptr, rtab};
                pg8::fill_rstd_table(S, ssq, rtab, 12);
                for (int rep = 0; rep < REP_FFNUP; ++rep) pg8::gemm_phase<pg8::EpiSwiglu<false>, pg8::StaticOrder, true, true, false>(F.lds, gm, S, E);
            }
            SEAM();
            if (EN(8) && RUN()) {
                pg8::Gemm gm{F.ws + WS_A1, F.ws + WS_WDN, FF * 2, FF * 2, FF / 64, 0};
                pg8::StaticOrder S; S.init(T, D, F.G, wg_index());
                pg8::EpiResid E{XB, nullptr, XB, ssq, F.ws + WS_XB8G};
                pg8::gemm_phase<pg8::EpiResid, pg8::StaticOrder, true, true, false>(F.lds, gm, S, E);
            }
            SEAM();
        } else {
            MoeP M{asg(kargs()->in[18]), asg(kargs()->in[19]), asg(kargs()->in[20]), asg(kargs()->in[21]), asg(kargs()->in[22]), asg(kargs()->in[14]) + D};
            if (EN(9) && RUN()) {
                __syncthreads();
                moe_R1(F, M, (const bf16_t*)out, ssq);
            }
            SEAM();
            if (EN(10) && RUN()) {
                int woff = 0;
                for (int er = 0; er < NE * REP_CONV; ++er) { const int e = er % NE;
                    unsigned char* wd = F.ws + WS_WMOE + (size_t)e * WMOE_E_BYTES;
                    convert_w<true>(F, woff, FFE, D, 2 * FFE, wd, D, 0, M.norm2_w, MapGateUp{M.w_gate + (size_t)e * D * FFE, M.w_up + (size_t)e * D * FFE});
                    convert_w<true>(F, woff, D, FFE, D, wd + WMOE_UP_BYTES, FFE, 0, nullptr, MapIdent{M.w_down + (size_t)e * FFE * D});
                }
                moe_R2(F, (const bf16_t*)out);
            }
            SEAM();
            if (EN(11) && RUN()) {
                pg8::Gemm gm{F.ws + WS_XG, F.ws + WS_WMOE, D, D, D / 128, (unsigned)WMOE_E_BYTES};
                pg8::MoeOrder S; S.init_moe((const int*)(F.ws + WS_TS), 2 * FFE, F.G, wg_index());
                pg8::EpiSwiglu<true> E{F.ws + WS_AE, FFE, (const float*)(F.ws + WS_SLOTRS), nullptr};
                for (int rep = 0; rep < REP_MUP; ++rep) pg8::gemm_phase<pg8::EpiSwiglu<true>, pg8::MoeOrder, true, false, true>(F.lds, gm, S, E);
            }
            SEAM();
            if (EN(12) && RUN()) {
                pg8::Gemm gm{F.ws + WS_AE, F.ws + WS_WMOE + WMOE_UP_BYTES, FFE, FFE, FFE / 128, (unsigned)WMOE_E_BYTES};
                pg8::MoeOrder S; S.init_moe((const int*)(F.ws + WS_TS), D, F.G, wg_index());
                pg8::EpiMoeDown E{(bf16_t*)(F.ws + WS_YD), 1};
                pg8::gemm_phase<pg8::EpiMoeDown, pg8::MoeOrder, true, false, true>(F.lds, gm, S, E);
            }
            SEAM();
            if (EN(13) && RUN()) moe_combine(F, out, (const bf16_t*)out);
            SEAM();
        }
    }
#undef RUN
#undef SEAM
#undef x_in
#undef lo
#undef hi
#undef out
#undef ssq
#undef XB
}

#ifndef MK_PER_PHASE
#define MK_PER_PHASE 0
#endif
extern "C" void kernel_launch(void* const* d_in, const int* in_sizes, int n_in, void* d_out, int out_size, void* d_ws, size_t ws_size, hipStream_t stream) {
    static int grid = 0;
    if (grid == 0) {
        if (n_in != 23 || out_size != T * D || ws_size < WS_NEED) { fprintf(stderr, "kernel_launch: unexpected problem shape / workspace (%d inputs, out %d, ws %zu < %zu)\n", n_in, out_size, ws_size, (size_t)WS_NEED); grid = -1; return; }
        int dev = 0, cus = 0, per_cu = 0;
        if (hipGetDevice(&dev) != hipSuccess || hipDeviceGetAttribute(&cus, hipDeviceAttributeMultiprocessorCount, dev) != hipSuccess) { grid = -1; return; }
        if (hipFuncSetAttribute((const void*)fwd, hipFuncAttributeMaxDynamicSharedMemorySize, LDS_BYTES) != hipSuccess) { grid = -1; return; }
        if (hipOccupancyMaxActiveBlocksPerMultiprocessor(&per_cu, (const void*)fwd, 512, LDS_BYTES) != hipSuccess || per_cu < 1) { fprintf(stderr, "kernel_launch: occupancy query reports %d\n", per_cu); }
        (void)hipGetLastError();
        grid = cus;
    }
    if (grid < 0) return;
    if (hipMemsetAsync((char*)d_ws + WS_CTL, 0, CTL_ZERO_BYTES, stream) != hipSuccess) return;
    Args a{};
    for (int i = 0; i < 23; ++i) a.in[i] = (const float*)d_in[i];
    a.out = (float*)d_out; a.ws = (unsigned char*)d_ws;
#if MK_PER_PHASE
    for (int p = 0; p < NPHASES; ++p) { a.ph_lo = p; a.ph_hi = p + 1; a.li = p; hipLaunchKernelGGL(fwd, dim3(grid), dim3(512), LDS_BYTES, stream, a); }
#else
    a.ph_lo = 0; a.ph_hi = 1 << 20; a.li = 0;
    hipLaunchKernelGGL(fwd, dim3(grid), dim3(512), LDS_BYTES, stream, a);
#endif
}
```
